# Optimizing an MI355X kernel written in HIP

```python
import math
import jax, jax.numpy as jnp
from jax import lax
import numpy as np

D_MODEL = 1024
BATCH = 2
SEQ = 8192
DEPTH = 1
DEC_BATCH = 8
DEC_SEQ = 64
PAST_LEN = 2048

CHUNK = 64
N_SUBLAYERS = 3
FFN_RES = 0.5
FF_DIM = 2816
RMS_EPS = 1e-6
S5_WIDTH = D_MODEL // 2
S5_GROUP = 16
S5_GROUPS = S5_WIDTH // S5_GROUP
S5_STATE = 64
HEAD_DIM = 64
N_HEADS = (D_MODEL // 2) // HEAD_DIM
N_KV_HEADS = 2
GQA_REP = N_HEADS // N_KV_HEADS
WINDOW = 128
WIN_CHUNKS = WINDOW // CHUNK
WIN_CACHE = min(WINDOW, PAST_LEN)
ROPE_THETA = 500000.0
ROPE_DIM = HEAD_DIM // 4
ATTN_SCALE = HEAD_DIM ** -0.5
NEG_INF = -1e30
Q_WIDTH = N_HEADS * HEAD_DIM
KV_WIDTH = N_KV_HEADS * HEAD_DIM
IN_WIDTH = S5_WIDTH + Q_WIDTH + 2 * KV_WIDTH + 2 * D_MODEL
IN_SPLITS = (S5_WIDTH,
             S5_WIDTH + Q_WIDTH,
             S5_WIDTH + Q_WIDTH + KV_WIDTH,
             S5_WIDTH + Q_WIDTH + 2 * KV_WIDTH,
             S5_WIDTH + Q_WIDTH + 2 * KV_WIDTH + D_MODEL)

kernel_name = 'hybrid_s5_swa_macaron_stream_step'


def rmsnorm(x, g):
    xf = x.astype(jnp.float32)
    y = xf * lax.rsqrt(jnp.mean(xf * xf, axis=-1, keepdims=True) + RMS_EPS)
    return (y * g.astype(jnp.float32)).astype(x.dtype)


def modulate(x, g, shift, scale):
    return rmsnorm(x, g) * (1.0 + scale) + shift


def swiglu(h, w_in, w_out):
    a, b = jnp.split(h @ w_in, 2, axis=-1)
    return (jax.nn.silu(a) * b) @ w_out


def adaln_params(c, w_ada, b_ada):
    mod = jax.nn.silu(c) @ w_ada + b_ada
    return mod.reshape(c.shape[0], N_SUBLAYERS, 3, 1, D_MODEL)


def partial_rope(x, pos):
    half = ROPE_DIM // 2
    inv_freq = ROPE_THETA ** (-jnp.arange(half, dtype=jnp.float32) / half)
    ang = pos.astype(jnp.float32)[:, None] * inv_freq[None, :]
    cos = jnp.cos(ang)[None, :, None, :]
    sin = jnp.sin(ang)[None, :, None, :]
    xr = x[..., :ROPE_DIM].astype(jnp.float32)
    x1, x2 = xr[..., :half], xr[..., half:]
    rot = jnp.concatenate([x1 * cos - x2 * sin, x2 * cos + x1 * sin], axis=-1)
    return jnp.concatenate([rot.astype(x.dtype), x[..., ROPE_DIM:]], axis=-1)


def project_inputs(u, w_in, q_norm, k_norm, pos):
    b, l = u.shape[:2]
    s5_u, q, k, v, g_s5, g_attn = jnp.split(u @ w_in, IN_SPLITS, axis=-1)
    q = q.reshape(b, l, N_HEADS, HEAD_DIM)
    k = k.reshape(b, l, N_KV_HEADS, HEAD_DIM)
    v = v.reshape(b, l, N_KV_HEADS, HEAD_DIM)
    q = partial_rope(rmsnorm(q, q_norm), pos)
    k = partial_rope(rmsnorm(k, k_norm), pos)
    return s5_u, q, k, v, jax.nn.sigmoid(g_s5), jax.nn.sigmoid(g_attn)


def s5_discretise(log_dt, a_re, a_im, b_re, b_im):
    dt = jnp.exp(log_dt.astype(jnp.float32))[:, None]
    lr = jnp.minimum(a_re.astype(jnp.float32), -1e-4)
    li = a_im.astype(jnp.float32)
    mag = jnp.exp(lr * dt)
    ab_re = mag * jnp.cos(li * dt)
    ab_im = mag * jnp.sin(li * dt)
    nr, ni = ab_re - 1.0, ab_im
    den = lr * lr + li * li
    f_re = (nr * lr + ni * li) / den
    f_im = (ni * lr - nr * li) / den
    br, bi = b_re.astype(jnp.float32), b_im.astype(jnp.float32)
    bb_re = f_re[..., None] * br - f_im[..., None] * bi
    bb_im = f_re[..., None] * bi + f_im[..., None] * br
    return ab_re, ab_im, bb_re, bb_im


def s5_combine(e1, e2):
    a1r, a1i, b1r, b1i = e1
    a2r, a2i, b2r, b2i = e2
    return (a2r * a1r - a2i * a1i,
            a2r * a1i + a2i * a1r,
            a2r * b1r - a2i * b1i + b2r,
            a2r * b1i + a2i * b1r + b2i)


def s5_branch(u, h0_re, h0_im, p):
    b, l = u.shape[:2]
    ug = u.reshape(b, l, S5_GROUPS, S5_GROUP).astype(jnp.float32)
    ab_re, ab_im, bb_re, bb_im = s5_discretise(p['s5_log_dt'], p['s5_a_re'], p['s5_a_im'],
                                               p['s5_b_re'], p['s5_b_im'])
    bu_re = jnp.einsum('gpc,blgc->blgp', bb_re, ug)
    bu_im = jnp.einsum('gpc,blgc->blgp', bb_im, ug)
    if h0_re is not None:
        hr, hi = h0_re.astype(jnp.float32), h0_im.astype(jnp.float32)
        bu_re = bu_re.at[:, 0].add(ab_re * hr - ab_im * hi)
        bu_im = bu_im.at[:, 0].add(ab_re * hi + ab_im * hr)
    a_re = jnp.broadcast_to(ab_re, bu_re.shape)
    a_im = jnp.broadcast_to(ab_im, bu_im.shape)
    _, _, h_re, h_im = lax.associative_scan(s5_combine, (a_re, a_im, bu_re, bu_im), axis=1)
    y = (jnp.einsum('gcp,blgp->blgc', p['s5_c_re'].astype(jnp.float32), h_re)
         - jnp.einsum('gcp,blgp->blgc', p['s5_c_im'].astype(jnp.float32), h_im)
         + p['s5_d'].astype(jnp.float32) * ug)
    y = jax.nn.gelu(y.reshape(b, l, S5_WIDTH).astype(u.dtype))
    y = y * jax.nn.sigmoid(y @ p['w_glu'] + p['b_glu'])
    return y @ p['w_s5_proj'], h_re[:, -1].astype(u.dtype), h_im[:, -1].astype(u.dtype)


def sink_softmax(s, sink):
    m = jnp.maximum(jnp.max(s, axis=-1, keepdims=True), sink)
    e = jnp.exp(s - m)
    return e / (jnp.sum(e, axis=-1, keepdims=True) + jnp.exp(sink - m))


def banded_window_attention(q, k, v, sinks):
    b, l = q.shape[:2]
    nc = l // CHUNK
    span = (WIN_CHUNKS + 1) * CHUNK
    qc = q.reshape(b, nc, CHUNK, N_KV_HEADS, GQA_REP, HEAD_DIM)
    kc = k.reshape(b, nc, CHUNK, N_KV_HEADS, HEAD_DIM)
    vc = v.reshape(b, nc, CHUNK, N_KV_HEADS, HEAD_DIM)
    pad = ((0, 0), (WIN_CHUNKS, 0), (0, 0), (0, 0), (0, 0))
    kp, vp = jnp.pad(kc, pad), jnp.pad(vc, pad)
    kb = jnp.concatenate([kp[:, j:j + nc] for j in range(WIN_CHUNKS + 1)], axis=2)
    vb = jnp.concatenate([vp[:, j:j + nc] for j in range(WIN_CHUNKS + 1)], axis=2)
    s = jnp.einsum('bnqkrd,bnskd->bnkrqs', qc, kb, preferred_element_type=jnp.float32) * ATTN_SCALE
    key_chunk = jnp.arange(nc)[:, None] + (jnp.arange(span) // CHUNK - WIN_CHUNKS)[None, :]
    s = jnp.where((key_chunk >= 0)[None, :, None, None, None, :], s, NEG_INF)
    sink = sinks.astype(jnp.float32).reshape(1, 1, N_KV_HEADS, GQA_REP, 1, 1)
    w = sink_softmax(s, sink)
    o = jnp.einsum('bnkrqs,bnskd->bnqkrd', w.astype(v.dtype), vb)
    return o.reshape(b, l, Q_WIDTH), k[:, -WIN_CACHE:], v[:, -WIN_CACHE:]


def cached_window_attention(q, k, v, cache_k, cache_v, sinks):
    b, l = q.shape[:2]
    kk = jnp.concatenate([cache_k.astype(k.dtype), k], axis=1)
    vv = jnp.concatenate([cache_v.astype(v.dtype), v], axis=1)
    qg = q.reshape(b, l, N_KV_HEADS, GQA_REP, HEAD_DIM)
    s = jnp.einsum('bqkrd,bskd->bkrqs', qg, kk, preferred_element_type=jnp.float32) * ATTN_SCALE
    sink = sinks.astype(jnp.float32).reshape(1, N_KV_HEADS, GQA_REP, 1, 1)
    w = sink_softmax(s, sink)
    o = jnp.einsum('bkrqs,bskd->bqkrd', w.astype(vv.dtype), vv)
    return o.reshape(b, l, Q_WIDTH), kk[:, -WIN_CACHE:], vv[:, -WIN_CACHE:]


def trunk_layer(x, c, pos, p, cache_k=None, cache_v=None, h0_re=None, h0_im=None):
    mod = adaln_params(c, p['w_ada'], p['b_ada'])
    h = x + FFN_RES * mod[:, 0, 2] * swiglu(modulate(x, p['norm_ffn1'], mod[:, 0, 0], mod[:, 0, 1]),
                                            p['w_ffn1_in'], p['w_ffn1_out'])
    u = modulate(h, p['norm_mix'], mod[:, 1, 0], mod[:, 1, 1])
    s5_u, q, k, v, g_s5, g_attn = project_inputs(u, p['w_in'], p['q_norm'], p['k_norm'], pos)
    y_s5, s_re, s_im = s5_branch(s5_u, h0_re, h0_im, p)
    if cache_k is None:
        o, k_win, v_win = banded_window_attention(q, k, v, p['attn_sinks'])
    else:
        o, k_win, v_win = cached_window_attention(q, k, v, cache_k, cache_v, p['attn_sinks'])
    y_attn = o @ p['w_attn_proj']
    merged = g_s5 * y_s5 + g_attn * y_attn
    h = h + mod[:, 1, 2] * (merged @ p['w_out'])
    h = h + FFN_RES * mod[:, 2, 2] * swiglu(modulate(h, p['norm_ffn2'], mod[:, 2, 0], mod[:, 2, 1]),
                                            p['w_ffn2_in'], p['w_ffn2_out'])
    return rmsnorm(h, p['norm_final']), (k_win, v_win, s_re, s_im)


def setup_inputs(seed: int = 0) -> dict:
    key = jax.random.key(seed)
    ks = iter(jax.random.split(key, 48))

    def nrm(shape, scale):
        return jax.random.normal(next(ks), shape, jnp.float32) * scale

    def gain(shape):
        return 1.0 + nrm(shape, 0.02)

    L = (DEPTH,)
    G, P, GC = S5_GROUPS, S5_STATE, S5_GROUP
    x_prompt = nrm((BATCH, SEQ, D_MODEL), 1.0)
    x_sample = nrm((DEC_BATCH, DEC_SEQ, D_MODEL), 1.0)
    cache_k = nrm(L + (DEC_BATCH, WIN_CACHE, N_KV_HEADS, HEAD_DIM), 1.0)
    cache_v = nrm(L + (DEC_BATCH, WIN_CACHE, N_KV_HEADS, HEAD_DIM), 1.0)
    state_s5_re = nrm(L + (DEC_BATCH, G, P), 0.1)
    state_s5_im = nrm(L + (DEC_BATCH, G, P), 0.1)
    c_prompt = nrm((BATCH, D_MODEL), 1.0)
    c_sample = nrm((DEC_BATCH, D_MODEL), 1.0)
    n_idx = jnp.arange(P, dtype=jnp.float32)
    return {
        'x_prompt': x_prompt,
        'x_sample': x_sample,
        'cache_k': cache_k,
        'cache_v': cache_v,
        'state_s5_re': state_s5_re,
        'state_s5_im': state_s5_im,
        'c_prompt': c_prompt,
        'c_sample': c_sample,
        'w_ada': nrm(L + (D_MODEL, N_SUBLAYERS * 3 * D_MODEL), 0.3 * D_MODEL ** -0.5),
        'b_ada': nrm(L + (N_SUBLAYERS * 3 * D_MODEL,), 0.02),
        'norm_ffn1': gain(L + (D_MODEL,)),
        'w_ffn1_in': nrm(L + (D_MODEL, 2 * FF_DIM), D_MODEL ** -0.5),
        'w_ffn1_out': nrm(L + (FF_DIM, D_MODEL), FF_DIM ** -0.5),
        'norm_mix': gain(L + (D_MODEL,)),
        'w_in': nrm(L + (D_MODEL, IN_WIDTH), D_MODEL ** -0.5),
        's5_log_dt': jax.random.uniform(next(ks), L + (G,), jnp.float32, math.log(1e-3), math.log(1e-1)),
        's5_a_re': -0.5 + nrm(L + (G, P), 0.01),
        's5_a_im': math.pi * n_idx + nrm(L + (G, P), 0.01),
        's5_b_re': nrm(L + (G, P, GC), (2.0 * GC) ** -0.5),
        's5_b_im': nrm(L + (G, P, GC), (2.0 * GC) ** -0.5),
        's5_c_re': nrm(L + (G, GC, P), P ** -0.5),
        's5_c_im': nrm(L + (G, GC, P), P ** -0.5),
        's5_d': nrm(L + (G, GC), 1.0),
        'w_glu': nrm(L + (S5_WIDTH, S5_WIDTH), S5_WIDTH ** -0.5),
        'b_glu': nrm(L + (S5_WIDTH,), 0.02),
        'w_s5_proj': nrm(L + (S5_WIDTH, D_MODEL), S5_WIDTH ** -0.5),
        'q_norm': gain(L + (HEAD_DIM,)),
        'k_norm': gain(L + (HEAD_DIM,)),
        'attn_sinks': nrm(L + (N_HEADS,), 0.5),
        'w_attn_proj': nrm(L + (Q_WIDTH, D_MODEL), Q_WIDTH ** -0.5),
        'w_out': nrm(L + (D_MODEL, D_MODEL), D_MODEL ** -0.5),
        'norm_ffn2': gain(L + (D_MODEL,)),
        'w_ffn2_in': nrm(L + (D_MODEL, 2 * FF_DIM), D_MODEL ** -0.5),
        'w_ffn2_out': nrm(L + (FF_DIM, D_MODEL), FF_DIM ** -0.5),
        'norm_final': gain(L + (D_MODEL,)),
    }


def reference(x_prompt, x_sample, cache_k, cache_v, state_s5_re, state_s5_im, c_prompt, c_sample,
              w_ada, b_ada, norm_ffn1, w_ffn1_in, w_ffn1_out, norm_mix, w_in,
              s5_log_dt, s5_a_re, s5_a_im, s5_b_re, s5_b_im, s5_c_re, s5_c_im, s5_d,
              w_glu, b_glu, w_s5_proj, q_norm, k_norm, attn_sinks, w_attn_proj, w_out,
              norm_ffn2, w_ffn2_in, w_ffn2_out, norm_final):
    pos_prompt = jnp.arange(x_prompt.shape[1])
    pos_sample = PAST_LEN + jnp.arange(x_sample.shape[1])
    y_prompt, y_sample = x_prompt, x_sample
    st_prompt, st_sample = [], []
    for l in range(DEPTH):
        p = {
            'w_ada': w_ada[l], 'b_ada': b_ada[l], 'norm_ffn1': norm_ffn1[l],
            'w_ffn1_in': w_ffn1_in[l], 'w_ffn1_out': w_ffn1_out[l], 'norm_mix': norm_mix[l],
            'w_in': w_in[l], 's5_log_dt': s5_log_dt[l], 's5_a_re': s5_a_re[l], 's5_a_im': s5_a_im[l],
            's5_b_re': s5_b_re[l], 's5_b_im': s5_b_im[l], 's5_c_re': s5_c_re[l], 's5_c_im': s5_c_im[l],
            's5_d': s5_d[l], 'w_glu': w_glu[l], 'b_glu': b_glu[l], 'w_s5_proj': w_s5_proj[l],
            'q_norm': q_norm[l], 'k_norm': k_norm[l], 'attn_sinks': attn_sinks[l],
            'w_attn_proj': w_attn_proj[l], 'w_out': w_out[l], 'norm_ffn2': norm_ffn2[l],
            'w_ffn2_in': w_ffn2_in[l], 'w_ffn2_out': w_ffn2_out[l], 'norm_final': norm_final[l],
        }
        y_prompt, sp = trunk_layer(y_prompt, c_prompt, pos_prompt, p)
        y_sample, ss = trunk_layer(y_sample, c_sample, pos_sample, p,
                                   cache_k[l], cache_v[l], state_s5_re[l], state_s5_im[l])
        st_prompt.append(sp)
        st_sample.append(ss)
    k_win_prompt = jnp.stack([s[0] for s in st_prompt])
    v_win_prompt = jnp.stack([s[1] for s in st_prompt])
    s5_re_prompt = jnp.stack([s[2] for s in st_prompt])
    s5_im_prompt = jnp.stack([s[3] for s in st_prompt])
    k_win_sample = jnp.stack([s[0] for s in st_sample])
    v_win_sample = jnp.stack([s[1] for s in st_sample])
    s5_re_sample = jnp.stack([s[2] for s in st_sample])
    s5_im_sample = jnp.stack([s[3] for s in st_sample])
    return (y_prompt, y_sample, k_win_prompt, v_win_prompt, s5_re_prompt, s5_im_prompt,
            k_win_sample, v_win_sample, s5_re_sample, s5_im_sample)
```

```cpp
#include <hip/hip_runtime.h>
#include <cstdio>
#include <cstdint>
namespace pg8 {
#define PG8_LAS __attribute__((address_space(3)))
typedef unsigned short bf16_t;
typedef short bf16x8 __attribute__((ext_vector_type(8)));
typedef float f32x4 __attribute__((ext_vector_type(4)));
typedef unsigned u32x4 __attribute__((ext_vector_type(4)));
constexpr int BM = 256, BK = 64, HALF = 128, HTB = HALF * BK * 2  , STAGE_BYTES = 8 * HTB, NXCD = 8, WGM = 8;

__host__ __device__ __forceinline__ int lds_byte(int r, int c) { const int st = (r >> 4) * 2 + (c >> 5), rr = r & 15, cc = c & 31, ob = rr * 64 + cc * 2; return st * 1024 + (ob ^ (((ob >> 9) & 1) << 5)); }
__host__ __device__ __forceinline__ void stage_rc(int b, int& R, int& C) { const int st = b / 1024, sb = b % 1024, swz = sb ^ (((sb >> 9) & 1) << 5); R = (st >> 1) * 16 + swz / 64; C = (st & 1) * 32 + (swz % 64) / 2; }
__host__ __device__ __forceinline__ int perm32(int rho) { const int n = rho >> 4, i = rho & 15; return 8 * (i >> 2) + 4 * n + (i & 3); }

struct Unit { int pm, pn; };
struct Gemm { const bf16_t* A; const bf16_t* Bt; int M, N, K; };

struct StaticOrder {
    int nM, nN, nwg, G, c;
    __host__ __device__ void init(int M, int N, int G_, int c_) { nM = M / BM; nN = N / BM; nwg = nM * nN; G = G_; c = c_; }
    __host__ __device__ bool next(int i, Unit& u) const {
        const long L = (long)i * G + c; if (L >= nwg) return false;
        int wgid = (int)L; { const int q = nwg / NXCD, r = nwg % NXCD, xcd = wgid % NXCD, off = wgid / NXCD; wgid = (xcd < r ? xcd * (q + 1) : r * (q + 1) + (xcd - r) * q) + off; }
        const int nig = WGM * nN, gid = wgid / nig, fm = gid * WGM, gsz = (nM - fm) < WGM ? (nM - fm) : WGM;
        u.pm = fm + ((wgid % nig) % gsz); u.pn = (wgid % nig) / gsz; return true;
    }
    __device__ __forceinline__ void a_ready(const Unit&) const {}
    __device__ __forceinline__ void done(const Unit&) const {}
};
__device__ __forceinline__ unsigned cvt_pk_bf16(float lo, float hi) { unsigned r; asm volatile("v_cvt_pk_bf16_f32 %0, %1, %2" : "=v"(r) : "v"(lo), "v"(hi)); return r; }
typedef float f32x2 __attribute__((ext_vector_type(2)));
constexpr int R_MP = 16384, R_M = 16896;
__device__ __forceinline__ float bf_lo(unsigned w) { return __uint_as_float(w << 16); }
__device__ __forceinline__ float bf_hi(unsigned w) { return __uint_as_float(w & 0xffff0000u); }
__device__ __forceinline__ float fast_sigmoid(float x) { return __builtin_amdgcn_rcpf(1.0f + __builtin_amdgcn_exp2f(-1.4426950408889634f * x)); }
__device__ __forceinline__ u32x4 pack8(const f32x4 a, const f32x4 b) { u32x4 w; w.x = cvt_pk_bf16(a[0], a[1]); w.y = cvt_pk_bf16(a[2], a[3]); w.z = cvt_pk_bf16(b[0], b[1]); w.w = cvt_pk_bf16(b[2], b[3]); return w; }
__device__ __forceinline__ void unpack8(const u32x4 w, f32x4& a, f32x4& b) { a = (f32x4){bf_lo(w.x), bf_hi(w.x), bf_lo(w.y), bf_hi(w.y)}; b = (f32x4){bf_lo(w.z), bf_hi(w.z), bf_lo(w.w), bf_hi(w.w)}; }

struct EpiSwiglu {
    static constexpr bool PERM = true, AFTER_DRAIN = false;
    bf16_t* O; int ldo;
    __device__ __forceinline__ void operator()(const f32x4 (&acc)[2][2][4][2], const Unit& u, int wr, int wc, int fr, int fq) const {
        const int row0 = u.pm * BM + wr * 64 + fr, col0 = u.pn * HALF + wc * 32 + 8 * fq;
#pragma unroll
        for (int ai = 0; ai < 2; ++ai)
#pragma unroll
            for (int m = 0; m < 4; ++m) {
                f32x4 o[2];
#pragma unroll
                for (int n = 0; n < 2; ++n) { const f32x4 a = acc[ai][0][m][n], b = acc[ai][1][m][n];
#pragma unroll
                    for (int j = 0; j < 4; ++j) o[n][j] = a[j] * fast_sigmoid(a[j]) * b[j]; }
                *(u32x4*)(O + (size_t)(row0 + ai * HALF + m * 16) * ldo + col0) = pack8(o[0], o[1]);
            }
    }
};

struct EpiResid {
    static constexpr bool PERM = false, AFTER_DRAIN = false;
    const float* xp; const float* xs; float* H; const float* gate;
    float scale; int from_x;
    __device__ __forceinline__ void operator()(const f32x4 (&acc)[2][2][4][2], const Unit& u, int wr, int wc, int fr, int fq) const {
        const int col0 = u.pn * BM + wc * 32 + 4 * fq;
#pragma unroll
        for (int ai = 0; ai < 2; ++ai) {
            const int s = u.pm < 64 ? (u.pm >> 5) : 2 + (u.pm - 64) * 4 + ai * 2 + wr;
            f32x4 g[2][2];
#pragma unroll
            for (int bj = 0; bj < 2; ++bj)
#pragma unroll
                for (int n = 0; n < 2; ++n) g[bj][n] = *(const f32x4*)(gate + (size_t)s * 9216 + col0 + bj * HALF + n * 16) * scale;
#pragma unroll
            for (int m = 0; m < 4; ++m) {
                const int r = u.pm * BM + ai * HALF + wr * 64 + m * 16 + fr;
                const float* src = from_x ? (r < R_MP ? xp + (size_t)r * 1024 : xs + (size_t)(r - R_MP) * 1024) : (const float*)H + (size_t)r * 1024;
                float* dst = H + (size_t)r * 1024;
#pragma unroll
                for (int bj = 0; bj < 2; ++bj)
#pragma unroll
                    for (int n = 0; n < 2; ++n) { const int c = col0 + bj * HALF + n * 16; const f32x4 b = *(const f32x4*)(src + c); *(f32x4*)(dst + c) = b + g[bj][n] * acc[ai][bj][m][n]; }
            }
        }
    }
};

struct EpiWin {
    static constexpr bool PERM = true, AFTER_DRAIN = false;
    bf16_t *S5U, *Q, *KX, *VTP, *VTS, *GS5, *GATT;
    const float *qn, *kn, *rope;
    float* out;
    float qscale;
    __device__ __forceinline__ void operator()(const f32x4 (&acc)[2][2][4][2], const Unit& u, int wr, int wc, int fr, int fq) const {
        const int pn = u.pn, rowt = u.pm * BM + wr * 64 + fr;
        if (pn < 2 || pn >= 5) {
            bf16_t* base; int ld, cb; bool sig;
            if (pn < 2) { base = S5U; ld = 512; cb = pn * 256; sig = false; }
            else if (pn < 9) { base = GS5; ld = 1024; cb = (pn - 5) * 256; sig = true; }
            else { base = GATT; ld = 1024; cb = (pn - 9) * 256; sig = true; }
            const int col0 = cb + wc * 32 + 8 * fq;
#pragma unroll
            for (int ai = 0; ai < 2; ++ai)
#pragma unroll
                for (int m = 0; m < 4; ++m) { bf16_t* rowp = base + (size_t)(rowt + ai * HALF + m * 16) * ld + col0;
#pragma unroll
                    for (int bj = 0; bj < 2; ++bj) { f32x4 v0 = acc[ai][bj][m][0], v1 = acc[ai][bj][m][1];
                        if (sig) {
#pragma unroll
                            for (int j = 0; j < 4; ++j) { v0[j] = fast_sigmoid(v0[j]); v1[j] = fast_sigmoid(v1[j]); } }
                        *(u32x4*)(rowp + bj * HALF) = pack8(v0, v1); } }
            return;
        }
        const bool isv = (pn == 4) && (wc >= 2);
        if (!isv) {
            const bool isq = pn < 4;
            const int head = isq ? (pn - 2) * 4 + wc : wc;
            const float* gn = isq ? qn : kn;
            f32x4 gw[2][2];
#pragma unroll
            for (int bj = 0; bj < 2; ++bj)
#pragma unroll
                for (int n = 0; n < 2; ++n) gw[bj][n] = *(const f32x4*)(gn + 32 * bj + 8 * fq + 4 * n);
#pragma unroll
            for (int ai = 0; ai < 2; ++ai)
#pragma unroll
                for (int m = 0; m < 4; ++m) {
                    const int r = rowt + ai * HALF + m * 16;
                    const int pos = r < R_MP ? (r & 8191) : 2048 + ((r - R_MP) & 63);
                    float ss = 0.f;
#pragma unroll
                    for (int bj = 0; bj < 2; ++bj)
#pragma unroll
                        for (int n = 0; n < 2; ++n) { const f32x4 x = acc[ai][bj][m][n]; ss += (x[0] * x[0] + x[1] * x[1]) + (x[2] * x[2] + x[3] * x[3]); }
                    ss += __shfl_xor(ss, 16); ss += __shfl_xor(ss, 32);
                    const float rn = 1.0f / sqrtf(ss * (1.0f / 64.0f) + 1e-6f);
                    f32x4 v[2][2];
#pragma unroll
                    for (int bj = 0; bj < 2; ++bj)
#pragma unroll
                        for (int n = 0; n < 2; ++n) v[bj][n] = acc[ai][bj][m][n] * rn * gw[bj][n];
#pragma unroll
                    for (int n = 0; n < 2; ++n) {
                        const f32x4 cs = *(const f32x4*)(rope + (size_t)pos * 16 + 4 * n), sn = *(const f32x4*)(rope + (size_t)pos * 16 + 8 + 4 * n);
                        f32x4 pr;
#pragma unroll
                        for (int j = 0; j < 4; ++j) pr[j] = __shfl_xor(v[0][n][j], 16);
                        if (fq == 0) v[0][n] = v[0][n] * cs - pr * sn;
                        else if (fq == 1) v[0][n] = v[0][n] * cs + pr * sn;
                    }
                    if (isq) {
                        bf16_t* rowp = Q + (size_t)r * 512 + head * 64 + 8 * fq;
#pragma unroll
                        for (int bj = 0; bj < 2; ++bj) *(u32x4*)(rowp + 32 * bj) = pack8(v[bj][0] * qscale, v[bj][1] * qscale);
                    } else {
                        const int xr = r < R_MP ? r : R_MP + ((r - R_MP) >> 6) * 192 + 128 + ((r - R_MP) & 63);
                        bf16_t* rowp = KX + (size_t)xr * 128 + head * 64 + 8 * fq;
#pragma unroll
                        for (int bj = 0; bj < 2; ++bj) *(u32x4*)(rowp + 32 * bj) = pack8(v[bj][0], v[bj][1]);
                        float* wp = nullptr;
                        if (r < R_MP) { if (pos >= 8064) wp = out + 17301504 + (size_t)(((r >> 13) * 128 + (pos - 8064)) * 2 + head) * 64; }
                        else wp = out + 17375232 + (size_t)((((r - R_MP) >> 6) * 128 + 64 + ((r - R_MP) & 63)) * 2 + head) * 64;
                        if (wp) {
#pragma unroll
                            for (int bj = 0; bj < 2; ++bj)
#pragma unroll
                                for (int n = 0; n < 2; ++n) *(f32x4*)(wp + 32 * bj + 8 * fq + 4 * n) = v[bj][n];
                        }
                    }
                }
        } else {
            const int head = wc - 2;
#pragma unroll
            for (int ai = 0; ai < 2; ++ai)
#pragma unroll
                for (int m = 0; m < 4; ++m) {
                    const int r = rowt + ai * HALF + m * 16;
                    bf16_t* vt; size_t vstr; float* wp = nullptr;
                    if (r < R_MP) { const int b = r >> 13, pos = r & 8191; vt = VTP + (size_t)((b * 2 + head) * 64) * 8192 + pos; vstr = 8192;
                        if (pos >= 8064) wp = out + 17334272 + (size_t)((b * 128 + (pos - 8064)) * 2 + head) * 64; }
                    else { const int sb = (r - R_MP) >> 6, t = (r - R_MP) & 63; vt = VTS + (size_t)((sb * 2 + head) * 64) * 192 + 128 + t; vstr = 192;
                        wp = out + 17506304 + (size_t)((sb * 128 + 64 + t) * 2 + head) * 64; }
#pragma unroll
                    for (int bj = 0; bj < 2; ++bj)
#pragma unroll
                        for (int n = 0; n < 2; ++n) { const f32x4 x = acc[ai][bj][m][n]; const int d0 = 32 * bj + 8 * fq + 4 * n;
                            const unsigned w0 = cvt_pk_bf16(x[0], x[1]), w1 = cvt_pk_bf16(x[2], x[3]);
                            vt[(size_t)(d0 + 0) * vstr] = (bf16_t)(w0 & 0xffffu); vt[(size_t)(d0 + 1) * vstr] = (bf16_t)(w0 >> 16);
                            vt[(size_t)(d0 + 2) * vstr] = (bf16_t)(w1 & 0xffffu); vt[(size_t)(d0 + 3) * vstr] = (bf16_t)(w1 >> 16);
                            if (wp) *(f32x4*)(wp + d0) = x; }
                }
        }
    }
};

template <int MODE> struct EpiMix {
    static constexpr bool PERM = true, AFTER_DRAIN = false;
    bf16_t* O; const bf16_t* Y; const float* bias; int ld;
    __device__ __forceinline__ void operator()(const f32x4 (&acc)[2][2][4][2], const Unit& u, int wr, int wc, int fr, int fq) const {
        const int row0 = u.pm * BM + wr * 64 + fr, col0 = u.pn * BM + wc * 32 + 8 * fq;
#pragma unroll
        for (int ai = 0; ai < 2; ++ai)
#pragma unroll
            for (int m = 0; m < 4; ++m) { const size_t off = (size_t)(row0 + ai * HALF + m * 16) * ld + col0;
#pragma unroll
                for (int bj = 0; bj < 2; ++bj) {
                    const f32x4 a0 = acc[ai][bj][m][0], a1 = acc[ai][bj][m][1]; f32x4 o0, o1;
                    if (MODE == 0) { f32x4 y0, y1; unpack8(*(const u32x4*)(Y + off + bj * HALF), y0, y1);
                        const f32x4 b0 = *(const f32x4*)(bias + col0 + bj * HALF), b1 = *(const f32x4*)(bias + col0 + bj * HALF + 4);
#pragma unroll
                        for (int j = 0; j < 4; ++j) { o0[j] = y0[j] * fast_sigmoid(a0[j] + b0[j]); o1[j] = y1[j] * fast_sigmoid(a1[j] + b1[j]); } }
                    else if (MODE == 1) { f32x4 g0, g1; unpack8(*(const u32x4*)(O + off + bj * HALF), g0, g1); o0 = g0 * a0; o1 = g1 * a1; }
                    else { f32x4 t0, t1, g0, g1; unpack8(*(const u32x4*)(O + off + bj * HALF), t0, t1); unpack8(*(const u32x4*)(Y + off + bj * HALF), g0, g1); o0 = t0 + g0 * a0; o1 = t1 + g1 * a1; }
                    *(u32x4*)(O + off + bj * HALF) = pack8(o0, o1); } }
    }
};
template <class Epi, class Sched, bool ALIGN_EPI = false, bool SP2 = false>
__device__ __forceinline__ void gemm_phase(PG8_LAS unsigned char* lds, const Gemm g, const Sched& S, const Epi& E) {
    const int tid = threadIdx.x, wid = __builtin_amdgcn_readfirstlane(tid >> 6), lane = tid & 63, wr = wid >> 2, wc = wid & 3, fr = lane & 15, fq = lane >> 4;
    const int K = g.K, nt = K / BK;
    unsigned voffA[2], voffB[2];
#pragma unroll
    for (int i = 0; i < 2; ++i) { int R, C; stage_rc(tid * 16 + i * 8192, R, C); const int Rb = Epi::PERM ? ((R & ~31) + perm32(R & 31)) : R;
        voffA[i] = (unsigned)(R * K + C) * 2u; voffB[i] = (unsigned)(Rb * K + C) * 2u; }
    const size_t kstep = (size_t)(BK * 2);
    const size_t hstep = (size_t)HALF * K * 2;
    const size_t tstep = 2 * hstep;
    const unsigned ldsw = (unsigned)wid * 1024u;
    const int aoff = lds_byte(wr * 64 + fr, fq * 8), boff = lds_byte(wc * 32 + fr, fq * 8);
#define PG8_SA(b, h) (((b) * 2 + (h)) * HTB)
#define PG8_SB(b, h) ((4 + (b) * 2 + (h)) * HTB)
#define PG8_STAGE(bufoff, gbase, voff) do { _Pragma("unroll") for (int _i = 0; _i < 2; ++_i) \
        __builtin_amdgcn_global_load_lds((const unsigned*)((const char*)(gbase) + (voff)[_i]), (PG8_LAS unsigned*)(lds + (bufoff) + ldsw + _i * 8192), 16, 0, 0); } while (0)
#define PG8_LDA(dst, b, h) do { _Pragma("unroll") for (int m = 0; m < 4; ++m) _Pragma("unroll") for (int k = 0; k < 2; ++k) dst[m][k] = *(const PG8_LAS bf16x8*)(lds + PG8_SA(b, h) + aoff + m * 2048 + k * 1024); } while (0)
#define PG8_LDB(dst, b, h) do { _Pragma("unroll") for (int n = 0; n < 2; ++n) _Pragma("unroll") for (int k = 0; k < 2; ++k) dst[n][k] = *(const PG8_LAS bf16x8*)(lds + PG8_SB(b, h) + boff + n * 2048 + k * 1024); } while (0)
#define PG8_MMA(ai, bj, At, Bt) do { __builtin_amdgcn_s_setprio(1); _Pragma("unroll") for (int m = 0; m < 4; ++m) _Pragma("unroll") for (int n = 0; n < 2; ++n) _Pragma("unroll") for (int k = 0; k < 2; ++k) \
        acc[ai][bj][m][n] = __builtin_amdgcn_mfma_f32_16x16x32_bf16(Bt[n][k], At[m][k], acc[ai][bj][m][n], 0, 0, 0); __builtin_amdgcn_s_setprio(0); } while (0)
#define PG8_WAIT_V(n) asm volatile("s_waitcnt vmcnt(" #n ")" ::: "memory")
#define PG8_WAIT_L(n) asm volatile("s_waitcnt lgkmcnt(" #n ")" ::: "memory")
#define PG8_BAR __builtin_amdgcn_s_barrier()
#define PG8_SCHED __builtin_amdgcn_sched_barrier(0)
    Unit cur, nxt; int ui = 0;
    if (!S.next(0, cur)) return;
    f32x4 acc[2][2][4][2];
#pragma unroll
    for (int a = 0; a < 2; ++a)
#pragma unroll
        for (int b = 0; b < 2; ++b)
#pragma unroll
            for (int m = 0; m < 4; ++m)
#pragma unroll
                for (int n = 0; n < 2; ++n) acc[a][b][m][n] = (f32x4){0.f, 0.f, 0.f, 0.f};
    bf16x8 At[4][2], B0[2][2], B1[2][2];
    const char* cA = (const char*)g.A + (size_t)cur.pm * tstep; const char* cB = (const char*)g.Bt + (size_t)cur.pn * tstep;
    S.a_ready(cur);
    if constexpr (SP2) {
        PG8_STAGE(PG8_SB(0, 0), cB, voffB); PG8_STAGE(PG8_SB(0, 1), cB + hstep, voffB); PG8_STAGE(PG8_SA(0, 0), cA, voffA); PG8_STAGE(PG8_SA(0, 1), cA + hstep, voffA);
        if (wr == 1) PG8_BAR;
        PG8_WAIT_V(2); PG8_BAR;
        PG8_STAGE(PG8_SB(1, 0), cB + kstep, voffB); PG8_STAGE(PG8_SA(1, 0), cA + kstep, voffA); PG8_STAGE(PG8_SB(1, 1), cB + hstep + kstep, voffB);
        PG8_WAIT_V(6); PG8_BAR;
    } else {
        PG8_STAGE(PG8_SB(0, 0), cB, voffB); PG8_STAGE(PG8_SA(0, 0), cA, voffA); PG8_STAGE(PG8_SB(0, 1), cB + hstep, voffB); PG8_STAGE(PG8_SA(0, 1), cA + hstep, voffA);
        if (wr == 1) PG8_BAR;
        PG8_WAIT_V(4); PG8_BAR;
        PG8_STAGE(PG8_SB(1, 0), cB + kstep, voffB); PG8_STAGE(PG8_SA(1, 0), cA + kstep, voffA); PG8_STAGE(PG8_SB(1, 1), cB + hstep + kstep, voffB);
        PG8_WAIT_V(6); PG8_BAR;
    }
    for (;;) {
        const bool has_next = S.next(ui + 1, nxt);
        const char* nA = has_next ? (const char*)g.A + (size_t)nxt.pm * tstep : cA; const char* nB = has_next ? (const char*)g.Bt + (size_t)nxt.pn * tstep : cB;
        for (int t = 0; t < nt; t += 2) {
            const bool last = (t == nt - 2);
            const char* a1 = cA + (size_t)(t + 1) * kstep;
            const char* a2 = last ? nA : cA + (size_t)(t + 2) * kstep; const char* b2 = last ? nB : cB + (size_t)(t + 2) * kstep;
            const char* a3 = a2 + kstep; const char* b3 = b2 + kstep;
            if (last && has_next) S.a_ready(nxt);
            if constexpr (SP2) {
            PG8_LDB(B0, 0, 0); PG8_LDB(B1, 0, 1); PG8_SCHED; PG8_LDA(At, 0, 0); PG8_STAGE(PG8_SA(1, 1), a1 + hstep, voffA);
            PG8_WAIT_V(8); PG8_WAIT_L(0); PG8_BAR; PG8_MMA(0, 0, At, B0); PG8_MMA(0, 1, At, B1); PG8_BAR; PG8_SCHED;
            PG8_LDA(At, 0, 1); PG8_STAGE(PG8_SB(0, 0), b2, voffB); PG8_STAGE(PG8_SB(0, 1), b2 + hstep, voffB); PG8_STAGE(PG8_SA(0, 0), a2, voffA);
            PG8_WAIT_V(8); PG8_WAIT_L(0); PG8_BAR; PG8_MMA(1, 0, At, B0); PG8_MMA(1, 1, At, B1); PG8_BAR; PG8_SCHED;
            PG8_LDB(B0, 1, 0); PG8_LDB(B1, 1, 1); PG8_SCHED; PG8_LDA(At, 1, 0); PG8_STAGE(PG8_SA(0, 1), a2 + hstep, voffA);
            PG8_WAIT_V(8); PG8_WAIT_L(0); PG8_BAR; PG8_MMA(0, 0, At, B0); PG8_MMA(0, 1, At, B1); PG8_BAR; PG8_SCHED;
            PG8_LDA(At, 1, 1); PG8_STAGE(PG8_SB(1, 0), b3, voffB); PG8_STAGE(PG8_SB(1, 1), b3 + hstep, voffB); PG8_STAGE(PG8_SA(1, 0), a3, voffA);
            PG8_WAIT_V(8); PG8_WAIT_L(0); PG8_BAR; PG8_MMA(1, 0, At, B0); PG8_MMA(1, 1, At, B1); PG8_BAR; PG8_SCHED;
            } else {
            PG8_LDB(B0, 0, 0); PG8_SCHED; PG8_LDA(At, 0, 0); PG8_STAGE(PG8_SA(1, 1), a1 + hstep, voffA);
            PG8_WAIT_L(8); PG8_BAR; PG8_WAIT_L(0); PG8_MMA(0, 0, At, B0); PG8_BAR; PG8_SCHED;
            PG8_LDB(B1, 0, 1); PG8_STAGE(PG8_SB(0, 0), b2, voffB);
            PG8_BAR; PG8_WAIT_L(0); PG8_MMA(0, 1, At, B1); PG8_BAR;
            PG8_LDA(At, 0, 1); PG8_STAGE(PG8_SA(0, 0), a2, voffA);
            PG8_BAR; PG8_WAIT_L(0); PG8_MMA(1, 0, At, B0); PG8_BAR; PG8_SCHED;
            PG8_STAGE(PG8_SB(0, 1), b2 + hstep, voffB);
            PG8_WAIT_V(6); PG8_BAR; PG8_MMA(1, 1, At, B1); PG8_BAR;
            PG8_LDB(B0, 1, 0); PG8_SCHED; PG8_LDA(At, 1, 0); PG8_STAGE(PG8_SA(0, 1), a2 + hstep, voffA);
            PG8_WAIT_L(8); PG8_BAR; PG8_WAIT_L(0); PG8_MMA(0, 0, At, B0); PG8_BAR; PG8_SCHED;
            PG8_LDB(B1, 1, 1); PG8_STAGE(PG8_SB(1, 0), b3, voffB);
            PG8_BAR; PG8_WAIT_L(0); PG8_MMA(0, 1, At, B1); PG8_BAR;
            PG8_LDA(At, 1, 1); PG8_STAGE(PG8_SA(1, 0), a3, voffA);
            PG8_BAR; PG8_WAIT_L(0); PG8_MMA(1, 0, At, B0); PG8_BAR; PG8_SCHED;
            PG8_STAGE(PG8_SB(1, 1), b3 + hstep, voffB);
            PG8_WAIT_V(6); PG8_BAR; PG8_MMA(1, 1, At, B1); PG8_BAR;
            }
        }
        if constexpr (ALIGN_EPI) { if (wr == 0) PG8_BAR; }
        if constexpr (!Epi::AFTER_DRAIN) { E(acc, cur, wr, wc, fr, fq); S.done(cur); }
        if (!has_next) break;
#pragma unroll
        for (int a = 0; a < 2; ++a)
#pragma unroll
            for (int b = 0; b < 2; ++b)
#pragma unroll
                for (int m = 0; m < 4; ++m)
#pragma unroll
                    for (int n = 0; n < 2; ++n) acc[a][b][m][n] = (f32x4){0.f, 0.f, 0.f, 0.f};
        cur = nxt; cA = nA; cB = nB; ++ui;
        if constexpr (ALIGN_EPI) { if (wr == 1) PG8_BAR; }
    }
    PG8_WAIT_V(0);
    if constexpr (!ALIGN_EPI) { if (wr == 0) PG8_BAR; }
    PG8_BAR;
    if constexpr (Epi::AFTER_DRAIN) { E.fused(acc, cur, wr, wc, fr, fq, lds, wid, lane); S.done(cur); }
#undef PG8_SA
#undef PG8_SB
#undef PG8_STAGE
#undef PG8_LDA
#undef PG8_LDB
#undef PG8_MMA
#undef PG8_WAIT_V
#undef PG8_WAIT_L
#undef PG8_BAR
#undef PG8_SCHED
}
}
#define GAS __attribute__((address_space(1)))
#define LAS __attribute__((address_space(3)))
typedef unsigned short bf16;
typedef unsigned v4u __attribute__((ext_vector_type(4)));
typedef float f32x4 __attribute__((ext_vector_type(4)));
typedef short bf16x8 __attribute__((ext_vector_type(8)));
typedef GAS unsigned gu32;
typedef GAS unsigned long long gu64;
#define RLX_AGENT __ATOMIC_RELAXED, __HIP_MEMORY_SCOPE_AGENT
#define LDS_WAIT() asm volatile("s_waitcnt lgkmcnt(0)" ::: "memory")
#define VM_WAIT() asm volatile("s_waitcnt vmcnt(0)" ::: "memory")
__device__ __forceinline__ unsigned long long rt() { return __builtin_amdgcn_s_memrealtime(); }
__device__ __forceinline__ unsigned f2bf(float f) { unsigned u = __builtin_bit_cast(unsigned, f); return (u + 0x7fffu + ((u >> 16) & 1u)) >> 16; }
__device__ __forceinline__ unsigned pk2(float lo, float hi) { return f2bf(lo) | (f2bf(hi) << 16); }

#define XB_TMO      128
#define XB_XCNT(j)  (256  + 64 * (j))
#define XB_XSUB(j)  (1280 + 64 * (j))
#define XB_XGEN(j)  (2304 + 64 * (j))
#define XB_TOP      3328
#define XB_TOPGEN   3392
#define XCD_BAR_WORDS 3456
#define XB_SPIN_CAP (1u << 18)

__device__ __forceinline__ unsigned xb_ld(unsigned* p)              { return __hip_atomic_load(p, __ATOMIC_RELAXED, __HIP_MEMORY_SCOPE_AGENT); }
__device__ __forceinline__ unsigned xb_add(unsigned* p, unsigned v) { return __hip_atomic_fetch_add(p, v, __ATOMIC_RELAXED, __HIP_MEMORY_SCOPE_AGENT); }
__device__ __forceinline__ unsigned xb_xcc_id() { return (unsigned)__builtin_amdgcn_s_getreg((3 << 11) | 20) & 0xFu; }
#define XB_SPIN(cond, bar) do { unsigned _sp = 0; while (cond) { __builtin_amdgcn_s_sleep(1); \
    if ((++_sp & 255u) == 0u) { if (xb_ld(&(bar)[XB_TMO])) break; if (_sp > XB_SPIN_CAP) { atomicAdd(&(bar)[XB_TMO], 1u); break; } } } } while (0)

struct XcdBarrier {
    unsigned* bar; unsigned x;
    volatile LAS unsigned* st;
};

__device__ __forceinline__ XcdBarrier xcd_barrier_post(unsigned* bar, volatile LAS unsigned* st) {
    XcdBarrier b; b.bar = bar; b.x = xb_xcc_id(); b.st = st;
    if (threadIdx.x == 0) (void)xb_add(&bar[XB_XCNT(b.x)], 1u);
    return b;
}
__device__ __forceinline__ void xcd_barrier_complete(unsigned* bar, unsigned x, unsigned& nloc, unsigned& nx) {
    const unsigned G = gridDim.x * gridDim.y * gridDim.z;
    unsigned sum, cnt, mine, sp = 0u;
    for (;;) {
        sum = 0u; cnt = 0u; mine = 0u;
#pragma unroll
        for (unsigned j = 0; j < 16; ++j) { const unsigned c = xb_ld(&bar[XB_XCNT(j)]); sum += c; cnt += (c > 0u) ? 1u : 0u; mine = (j == x) ? c : mine; }
        if (sum == G) break;
        __builtin_amdgcn_s_sleep(1);
        if ((++sp & 255u) == 0u) { if (xb_ld(&bar[XB_TMO])) break; if (sp > XB_SPIN_CAP) { atomicAdd(&bar[XB_TMO], 1u); break; } }
    }
    nloc = mine > 0u ? mine : 1u; nx = cnt > 0u ? cnt : 1u;
}

__device__ __forceinline__ void xcd_barrier(const XcdBarrier& b) {
    asm volatile("s_waitcnt vmcnt(0)" ::: "memory");
    __syncthreads();
    if (threadIdx.x == 0) {
        unsigned* bar = b.bar;
        __builtin_amdgcn_s_waitcnt(0);
        unsigned nloc = b.st[0], nx = b.st[1];
        if (nloc == 0u) { xcd_barrier_complete(bar, b.x, nloc, nx); b.st[0] = nloc; b.st[1] = nx; }
        const unsigned old = xb_add(&bar[XB_XSUB(b.x)], 1u);
        const unsigned gen = old / nloc;
        if (old + 1u == (gen + 1u) * nloc) {
            __builtin_amdgcn_fence(__ATOMIC_RELEASE, "agent");
            asm volatile("s_waitcnt vmcnt(0)" ::: "memory");
            const unsigned og = xb_add(&bar[XB_TOP], 1u);
            const unsigned tg = og / nx;
            if (og + 1u == (tg + 1u) * nx) xb_add(&bar[XB_TOPGEN], 1u);
            else XB_SPIN(xb_ld(&bar[XB_TOPGEN]) == tg, bar);
            __builtin_amdgcn_fence(__ATOMIC_ACQUIRE, "agent");
            xb_add(&bar[XB_XGEN(b.x)], 1u);
            asm volatile("s_waitcnt vmcnt(0)" ::: "memory");
        } else {
            XB_SPIN(xb_ld(&bar[XB_XGEN(b.x)]) == gen, bar);
            __builtin_amdgcn_fence(__ATOMIC_ACQUIRE, "agent");
            asm volatile("s_waitcnt vmcnt(0)" ::: "memory");
        }
    }
    __syncthreads();
}
typedef unsigned u32x4q __attribute__((ext_vector_type(4)));
constexpr int NWAVES = 8;
#ifndef MK_SINGLE
#define MK_SINGLE 0
#endif
constexpr int DM = 1024, SEQ = 8192, NB = 2, DB = 8, DSEQ = 64, PAST = 2048, FF = 2816;
constexpr int MP = NB * SEQ, MS = DB * DSEQ, M = MP + MS;
constexpr int NSTREAM = NB + DB;
constexpr int NG = 32, GC = 16, NP = 64, S5W = 512, QW = 512, INW = 3328, NMOD = 9216;
constexpr int KXROWS = MP + DB * 192;
constexpr float RMS_EPS = 1e-6f;
constexpr float QSCALE = 0.125f * 1.4426950408889634f;
constexpr size_t O_Y = 0, O_KWP = 17301504, O_VWP = 17334272, O_S5RP = 17367040, O_S5IP = 17371136, O_KWS = 17375232, O_VWS = 17506304, O_S5RS = 17637376, O_S5IS = 17653760, O_END = 17670144;
constexpr size_t MiB = 1u << 20;
constexpr size_t WS_CTL = 0, CTL_ZERO_BYTES = 1 * MiB;
constexpr size_t WS_MOD = 1 * MiB;
constexpr size_t WS_ROPE = 1 * MiB + 512 * 1024;
constexpr size_t WS_S5AB = 2 * MiB;
constexpr size_t WS_S5BB = 2 * MiB + 64 * 1024;
constexpr size_t WS_W1I = 4 * MiB, WS_W1O = 15 * MiB, WS_W2I = 21 * MiB, WS_W2O = 32 * MiB, WS_WIN = 38 * MiB, WS_WGLU = 45 * MiB, WS_WS5P = 46 * MiB, WS_WAP = 47 * MiB, WS_WOUT = 48 * MiB;
constexpr size_t WS_XN = 50 * MiB;
constexpr size_t WS_A = 83 * MiB;
constexpr size_t WS_S5U = WS_A, WS_Q = WS_A + 17 * MiB, WS_KX = WS_A + 34 * MiB, WS_VTP = WS_A + 39 * MiB, WS_VTS = WS_A + 43 * MiB, WS_YS5 = WS_A + 44 * MiB, WS_Y2 = WS_A + 61 * MiB;
constexpr size_t WS_GS5 = 174 * MiB, WS_GATT = 207 * MiB, WS_END = 240 * MiB;
static_assert(WS_W1I + (size_t)2 * FF * DM * 2 <= WS_W1O && WS_W1O + (size_t)DM * FF * 2 <= WS_W2I && WS_W2I + (size_t)2 * FF * DM * 2 <= WS_W2O && WS_W2O + (size_t)DM * FF * 2 <= WS_WIN, "ws map 1");
static_assert(WS_WIN + (size_t)INW * DM * 2 <= WS_WGLU && WS_WOUT + (size_t)DM * DM * 2 <= WS_XN && WS_XN + (size_t)M * DM * 2 <= WS_A && WS_A + (size_t)M * FF * 2 <= WS_GS5, "ws map 2");
static_assert(WS_S5U + (size_t)M * 512 * 2 <= WS_Q && WS_Q + (size_t)M * 512 * 2 <= WS_KX && WS_KX + (size_t)KXROWS * 128 * 2 <= WS_VTP && WS_VTP + (size_t)4 * MiB <= WS_VTS && WS_VTS + (size_t)DB * 2 * 64 * 192 * 2 <= WS_YS5, "ws map 3");
static_assert(WS_YS5 + (size_t)M * 512 * 2 <= WS_Y2 && WS_Y2 + (size_t)M * 512 * 2 <= WS_GS5 && WS_GS5 + (size_t)M * DM * 2 <= WS_GATT && WS_GATT + (size_t)M * DM * 2 <= WS_END, "ws map 4");
constexpr int CW_TMO = 0, CW_CODE = 1, CW_BAR = 4096;
constexpr int RING_OFF = 0, RING_BYTES = 131072, LDSCTL_OFF = RING_BYTES, MISC_OFF = LDSCTL_OFF + 320, LDS_BYTES = 147456;

struct Args { const float* in[35]; float* out; unsigned char* ws; int ph_lo, ph_hi, li, pad; };
typedef const __attribute__((address_space(4))) Args* KArgs;
struct Frame {
    LAS unsigned char* lds; volatile LAS unsigned* MISC; gu32* ctl;
    int tid, lane, wave, vcu, G;
    KArgs ap; float* out; unsigned char* ws;
};
#define INP(k) (F.ap->in[k])
#define LAUNDER_ARGS() asm volatile("" : "+s"(F.ap))
__device__ __forceinline__ float wave_sum(float v) {
#pragma unroll
    for (int o = 1; o < 64; o <<= 1) v += __shfl_xor(v, o);
    return v;
}
__device__ __forceinline__ float bf2f(bf16 x) { return __uint_as_float((unsigned)x << 16); }
__device__ __forceinline__ int row_stream(int r) { return r < MP ? (r >> 13) : 2 + ((r - MP) >> 6); }

__device__ __forceinline__ void sincos_d(double x, double& s, double& c) {
    const double q = rint(x * 0.63661977236758134308);
    double r = fma(-q, 1.57079632673412561417e+00, x); r = fma(-q, 6.07710050650619224932e-11, r);
    const double r2 = r * r;
    double sp = 1.0 / 6227020800.0; sp = fma(sp, r2, -1.0 / 39916800.0); sp = fma(sp, r2, 1.0 / 362880.0); sp = fma(sp, r2, -1.0 / 5040.0); sp = fma(sp, r2, 1.0 / 120.0); sp = fma(sp, r2, -1.0 / 6.0);
    const double sr = fma(r * r2, sp, r);
    double cp = -1.0 / 87178291200.0; cp = fma(cp, r2, 1.0 / 479001600.0); cp = fma(cp, r2, -1.0 / 3628800.0); cp = fma(cp, r2, 1.0 / 40320.0); cp = fma(cp, r2, -1.0 / 720.0); cp = fma(cp, r2, 1.0 / 24.0); cp = fma(cp, r2, -0.5);
    const double cr = fma(r2, cp, 1.0);
    const int n = (int)((long long)q & 3);
    s = (n == 0) ? sr : (n == 1) ? cr : (n == 2) ? -sr : -cr;
    c = (n == 0) ? cr : (n == 1) ? -sr : (n == 2) ? -cr : sr;
}

__device__ __forceinline__ void transpose_item(const float* W, int K, int N, bf16* WT, int n0, int src0, int kb, LAS float* scr, int lane) {
    const int k0 = 64 * kb;
#pragma unroll 8
    for (int i = 0; i < 32; ++i) { const int kk = 2 * i + (lane >> 5); scr[kk * 33 + (lane & 31)] = W[(size_t)(k0 + kk) * N + src0 + (lane & 31)]; }
    LDS_WAIT(); asm volatile("" ::: "memory");
    const int c = lane & 7;
#pragma unroll
    for (int j = 0; j < 4; ++j) { const int n = (lane >> 3) + 8 * j; const LAS float* s = scr + (8 * c) * 33 + n;
        v4u o; o.x = pk2(s[0 * 33], s[1 * 33]); o.y = pk2(s[2 * 33], s[3 * 33]); o.z = pk2(s[4 * 33], s[5 * 33]); o.w = pk2(s[6 * 33], s[7 * 33]);
        *(GAS v4u*)(WT + (size_t)(n0 + n) * K + k0 + 8 * c) = o; }
    LDS_WAIT(); asm volatile("" ::: "memory");
}
__device__ __forceinline__ int src_ffn_in(int n0) { const int t = n0 >> 8, h = (n0 >> 7) & 1, i0 = n0 & 127; return h * FF + 128 * t + i0; }
__device__ __forceinline__ int src_win(int n0) {
    const int t = n0 >> 8, ct = n0 & 255;
    if (t < 2) return n0;
    const int bj = ct >> 7, wc = (ct >> 5) & 3;
    if (t < 4) return 512 + ((t - 2) * 4 + wc) * 64 + 32 * bj;
    if (t == 4) return (wc < 2 ? 1024 + wc * 64 : 1152 + (wc - 2) * 64) + 32 * bj;
    return 1280 + (n0 - 5 * 256);
}

__device__ __forceinline__ void p0_prologue(Frame& F) {
    {
        LAS float* sc = (LAS float*)(F.lds + RING_OFF);
        LAS float* red = (LAS float*)(F.lds + RING_OFF + 40960);
        const float* w_ada = INP(8); const float* b_ada = INP(9); float* mod = (float*)(F.ws + WS_MOD);
        bool did = false;
        for (int it = F.vcu; it < NMOD / 64; it += F.G) {
            if (!did) {
                for (int i = F.tid; i < NSTREAM * DM; i += NWAVES * 64) { const int s = i >> 10, k = i & 1023; const float c = s < NB ? INP(6)[s * DM + k] : INP(7)[(s - NB) * DM + k]; sc[i] = c / (1.0f + __expf(-c)); }
                __syncthreads(); did = true;
            }
            const int j = it * 64 + F.lane; float acc[NSTREAM];
#pragma unroll
            for (int s = 0; s < NSTREAM; ++s) acc[s] = 0.f;
            const int k0 = F.wave * 128;
#pragma unroll 4
            for (int k = 0; k < 128; ++k) { const float w = w_ada[(size_t)(k0 + k) * NMOD + j];
#pragma unroll
                for (int s = 0; s < NSTREAM; ++s) acc[s] += sc[s * DM + k0 + k] * w; }
#pragma unroll
            for (int s = 0; s < NSTREAM; ++s) red[(F.wave * NSTREAM + s) * 64 + F.lane] = acc[s];
            __syncthreads();
            for (int i = F.tid; i < NSTREAM * 64; i += NWAVES * 64) { const int s = i >> 6, l = i & 63; float v = b_ada[it * 64 + l];
#pragma unroll
                for (int w = 0; w < NWAVES; ++w) v += red[(w * NSTREAM + s) * 64 + l];
                mod[(size_t)s * NMOD + it * 64 + l] = v; }
            __syncthreads();
        }
        __syncthreads();
    }
    const int gw = F.vcu * NWAVES + F.wave, NGW = F.G * NWAVES;
    const int gt = F.vcu * NWAVES * 64 + F.tid, NGT = F.G * NWAVES * 64;
    {
        LAS float* scr = (LAS float*)(F.lds + RING_OFF + F.wave * 16384);
        constexpr int I_FI = (DM / 64) * (2 * FF / 32), I_FO = (FF / 64) * (DM / 32), I_IN = (DM / 64) * (INW / 32), I_GLU = (512 / 64) * (512 / 32), I_P = (512 / 64) * (DM / 32), I_O = (DM / 64) * (DM / 32);
        constexpr int NITEMS = 2 * I_FI + 2 * I_FO + I_IN + I_GLU + 2 * I_P + I_O;
        for (int it = gw; it < NITEMS; it += NGW) {
            int r = it;
            if (r < 2 * I_FI) { const int which = r / I_FI; r -= which * I_FI; const int nblk = 2 * FF / 32, kb = r / nblk, n0 = (r % nblk) * 32;
                transpose_item(which ? INP(32) : INP(11), DM, 2 * FF, (bf16*)(F.ws + (which ? WS_W2I : WS_W1I)), n0, src_ffn_in(n0), kb, scr, F.lane); continue; } r -= 2 * I_FI;
            if (r < 2 * I_FO) { const int which = r / I_FO; r -= which * I_FO; const int nblk = DM / 32, kb = r / nblk, n0 = (r % nblk) * 32;
                transpose_item(which ? INP(33) : INP(12), FF, DM, (bf16*)(F.ws + (which ? WS_W2O : WS_W1O)), n0, n0, kb, scr, F.lane); continue; } r -= 2 * I_FO;
            if (r < I_IN) { const int nblk = INW / 32, kb = r / nblk, n0 = (r % nblk) * 32; transpose_item(INP(14), DM, INW, (bf16*)(F.ws + WS_WIN), n0, src_win(n0), kb, scr, F.lane); continue; } r -= I_IN;
            if (r < I_GLU) { const int nblk = 512 / 32, kb = r / nblk, n0 = (r % nblk) * 32; transpose_item(INP(23), 512, 512, (bf16*)(F.ws + WS_WGLU), n0, n0, kb, scr, F.lane); continue; } r -= I_GLU;
            if (r < 2 * I_P) { const int which = r / I_P; r -= which * I_P; const int nblk = DM / 32, kb = r / nblk, n0 = (r % nblk) * 32;
                transpose_item(which ? INP(29) : INP(25), 512, DM, (bf16*)(F.ws + (which ? WS_WAP : WS_WS5P)), n0, n0, kb, scr, F.lane); continue; } r -= 2 * I_P;
            { const int nblk = DM / 32, kb = r / nblk, n0 = (r % nblk) * 32; transpose_item(INP(30), DM, DM, (bf16*)(F.ws + WS_WOUT), n0, n0, kb, scr, F.lane); }
        }
    }
    {
        float* rope = (float*)(F.ws + WS_ROPE);
        for (int i = gt; i < SEQ * 8; i += NGT) { const int pos = i >> 3, k = i & 7; const double f = exp(-(double)k * (1.0 / 8.0) * 13.122363377404328  );
            double s, c; sincos_d((double)pos * f, s, c); rope[pos * 16 + k] = (float)c; rope[pos * 16 + 8 + k] = (float)s; }
    }
    {
        float* ab = (float*)(F.ws + WS_S5AB); float* bb = (float*)(F.ws + WS_S5BB);
        for (int i = gt; i < NG * NP; i += NGT) { const int g = i >> 6;
            const double dt = exp((double)INP(15)[g]); const double lr = fmin((double)INP(16)[i], -1e-4), li = (double)INP(17)[i];
            const double mag = exp(lr * dt); double s, c; sincos_d(li * dt, s, c);
            const double are = mag * c, aim = mag * s, nr = are - 1.0, ni = aim, den = lr * lr + li * li;
            const double fre = (nr * lr + ni * li) / den, fim = (ni * lr - nr * li) / den;
            ab[i] = (float)are; ab[NG * NP + i] = (float)aim;
#pragma unroll
            for (int cch = 0; cch < GC; ++cch) { const double br = (double)INP(18)[i * GC + cch], bi = (double)INP(19)[i * GC + cch];
                bb[i * GC + cch] = (float)(fre * br - fim * bi); bb[NG * NP * GC + i * GC + cch] = (float)(fre * bi + fim * br); } }
    }
}

__device__ __forceinline__ void cache_convert(Frame& F) {
    const int gt = F.vcu * NWAVES * 64 + F.tid, NGT = F.G * NWAVES * 64;
    {
        bf16* KX = (bf16*)(F.ws + WS_KX); bf16* VTS = (bf16*)(F.ws + WS_VTS);
        const float* ck = INP(2); const float* cv = INP(3);
        for (int i = gt; i < DB * 128 * 128; i += NGT) { const int sb = i >> 14, w = (i >> 7) & 127, c = i & 127, kvh = c >> 6, d = c & 63;
            const float kvv = ck[i], vv = cv[i];
            KX[(size_t)(MP + sb * 192 + w) * 128 + c] = (bf16)f2bf(kvv);
            VTS[(size_t)((sb * 2 + kvh) * 64 + d) * 192 + w] = (bf16)f2bf(vv);
            if (w >= 64) { F.out[O_KWS + (size_t)(sb * 128 + (w - 64)) * 128 + c] = kvv; F.out[O_VWS + (size_t)(sb * 128 + (w - 64)) * 128 + c] = vv; } }
    }
}

__device__ __forceinline__ void modulate_pass(Frame& F, int sub, bool from_x, const float* gnorm) {
    const int gw = F.vcu * NWAVES + F.wave, NGW = F.G * NWAVES;
    const float* mod = (const float*)(F.ws + WS_MOD); bf16* XN = (bf16*)(F.ws + WS_XN);
    for (int r = gw; r < M; r += NGW) {
        const float* src = from_x ? (r < MP ? INP(0) + (size_t)r * DM : INP(1) + (size_t)(r - MP) * DM) : F.out + (size_t)r * DM;
        const int s = row_stream(r);
        const float* sh = mod + (size_t)s * NMOD + (sub * 3 + 0) * DM; const float* scl = mod + (size_t)s * NMOD + (sub * 3 + 1) * DM;
        const GAS f32x4* xr = (const GAS f32x4*)src + F.lane;
        f32x4 v[4]; float ss = 0.f;
#pragma unroll
        for (int j = 0; j < 4; ++j) { v[j] = xr[64 * j]; ss += (v[j].x * v[j].x + v[j].y * v[j].y) + (v[j].z * v[j].z + v[j].w * v[j].w); }
        const float rstd = 1.0f / sqrtf(wave_sum(ss) * (1.0f / DM) + RMS_EPS);
        GAS unsigned long long* o8 = (GAS unsigned long long*)(XN + (size_t)r * DM) + F.lane;
#pragma unroll
        for (int j = 0; j < 4; ++j) { const int c = 4 * F.lane + 256 * j; const f32x4 g = *(const f32x4*)(gnorm + c), a = *(const f32x4*)(scl + c), b = *(const f32x4*)(sh + c);
            const f32x4 y = v[j] * rstd * g * (a + 1.0f) + b;
            o8[64 * j] = (unsigned long long)pk2(y.x, y.y) | ((unsigned long long)pk2(y.z, y.w) << 32); }
    }
}
__device__ __forceinline__ void final_norm_pass(Frame& F) {
    const int gw = F.vcu * NWAVES + F.wave, NGW = F.G * NWAVES; const float* gnorm = INP(34);
    for (int r = gw; r < M; r += NGW) {
        GAS f32x4* xr = (GAS f32x4*)(F.out + (size_t)r * DM) + F.lane;
        f32x4 v[4]; float ss = 0.f;
#pragma unroll
        for (int j = 0; j < 4; ++j) { v[j] = xr[64 * j]; ss += (v[j].x * v[j].x + v[j].y * v[j].y) + (v[j].z * v[j].z + v[j].w * v[j].w); }
        const float rstd = 1.0f / sqrtf(wave_sum(ss) * (1.0f / DM) + RMS_EPS);
#pragma unroll
        for (int j = 0; j < 4; ++j) { const f32x4 g = *(const f32x4*)(gnorm + 4 * F.lane + 256 * j); xr[64 * j] = v[j] * rstd * g; }
    }
}

__device__ __forceinline__ float gelu_tanh(float x) { const float u = 0.7978845608028654f * (x + 0.044715f * x * x * x); const float e = __expf(2.0f * u); const float t = 1.0f - 2.0f / (e + 1.0f); return 0.5f * x * (1.0f + t); }
__device__ __forceinline__ void s5_naive_unit(Frame& F, int s, int g) {
    const int p = F.lane; const int L = s < NB ? SEQ : DSEQ; const int r0 = s < NB ? s * SEQ : MP + (s - NB) * DSEQ;
    const float* ab = (const float*)(F.ws + WS_S5AB); const float* bb = (const float*)(F.ws + WS_S5BB);
    const bf16* S5U = (const bf16*)(F.ws + WS_S5U); bf16* YS5 = (bf16*)(F.ws + WS_YS5);
    const float are = ab[g * NP + p], aim = ab[NG * NP + g * NP + p];
    float bre[GC], bim[GC], cre[GC], cim[GC];
#pragma unroll
    for (int c = 0; c < GC; ++c) { bre[c] = bb[(g * NP + p) * GC + c]; bim[c] = bb[NG * NP * GC + (g * NP + p) * GC + c]; cre[c] = INP(20)[(g * GC + c) * NP + p]; cim[c] = INP(21)[(g * GC + c) * NP + p]; }
    float hr = 0.f, hi = 0.f;
    if (s >= NB) { hr = INP(4)[((s - NB) * NG + g) * NP + p]; hi = INP(5)[((s - NB) * NG + g) * NP + p]; }
    const int cidx = ((p >> 5) & 1) * 8 + ((p >> 4) & 1) * 4 + ((p >> 3) & 1) * 2 + ((p >> 2) & 1);
    const float dsk = INP(22)[g * GC + cidx];
    for (int t = 0; t < L; ++t) {
        const u32x4q* up = (const u32x4q*)(S5U + (size_t)(r0 + t) * S5W + g * GC);
        const u32x4q w0 = up[0], w1 = up[1];
        float u[GC];
        u[0] = __uint_as_float(w0.x << 16); u[1] = __uint_as_float(w0.x & 0xffff0000u); u[2] = __uint_as_float(w0.y << 16); u[3] = __uint_as_float(w0.y & 0xffff0000u);
        u[4] = __uint_as_float(w0.z << 16); u[5] = __uint_as_float(w0.z & 0xffff0000u); u[6] = __uint_as_float(w0.w << 16); u[7] = __uint_as_float(w0.w & 0xffff0000u);
        u[8] = __uint_as_float(w1.x << 16); u[9] = __uint_as_float(w1.x & 0xffff0000u); u[10] = __uint_as_float(w1.y << 16); u[11] = __uint_as_float(w1.y & 0xffff0000u);
        u[12] = __uint_as_float(w1.z << 16); u[13] = __uint_as_float(w1.z & 0xffff0000u); u[14] = __uint_as_float(w1.w << 16); u[15] = __uint_as_float(w1.w & 0xffff0000u);
        float bur = 0.f, bui = 0.f;
#pragma unroll
        for (int c = 0; c < GC; ++c) { bur += bre[c] * u[c]; bui += bim[c] * u[c]; }
        const float nr = are * hr - aim * hi + bur, ni = are * hi + aim * hr + bui; hr = nr; hi = ni;
        float v[GC];
#pragma unroll
        for (int c = 0; c < GC; ++c) v[c] = cre[c] * hr - cim[c] * hi;
        float v8[8], v4[4], v2[2], v1;
#pragma unroll
        for (int i = 0; i < 8; ++i) { const bool up_ = (p & 32) != 0; const float send = up_ ? v[i] : v[i + 8]; const float keep = up_ ? v[i + 8] : v[i]; v8[i] = keep + __shfl_xor(send, 32); }
#pragma unroll
        for (int i = 0; i < 4; ++i) { const bool up_ = (p & 16) != 0; const float send = up_ ? v8[i] : v8[i + 4]; const float keep = up_ ? v8[i + 4] : v8[i]; v4[i] = keep + __shfl_xor(send, 16); }
#pragma unroll
        for (int i = 0; i < 2; ++i) { const bool up_ = (p & 8) != 0; const float send = up_ ? v4[i] : v4[i + 2]; const float keep = up_ ? v4[i + 2] : v4[i]; v2[i] = keep + __shfl_xor(send, 8); }
        { const bool up_ = (p & 4) != 0; const float send = up_ ? v2[0] : v2[1]; const float keep = up_ ? v2[1] : v2[0]; v1 = keep + __shfl_xor(send, 4); }
        v1 += __shfl_xor(v1, 2); v1 += __shfl_xor(v1, 1);
        float uc = u[0];
#pragma unroll
        for (int c = 1; c < GC; ++c) uc = (cidx == c) ? u[c] : uc;
        const float y = gelu_tanh(v1 + dsk * uc);
        if ((p & 3) == 0) YS5[(size_t)(r0 + t) * S5W + g * GC + cidx] = (bf16)f2bf(y);
    }
    float* ore = F.out + (s < NB ? O_S5RP + (size_t)(s * NG + g) * NP : O_S5RS + (size_t)((s - NB) * NG + g) * NP);
    float* oim = F.out + (s < NB ? O_S5IP + (size_t)(s * NG + g) * NP : O_S5IS + (size_t)((s - NB) * NG + g) * NP);
    ore[p] = hr; oim[p] = hi;
}

typedef float f32x16 __attribute__((ext_vector_type(16)));
typedef unsigned u32x2q __attribute__((ext_vector_type(2)));
__device__ __forceinline__ void attn_wave_unit(Frame& F, int ck, int head) {
    const int lane = F.lane, l31 = lane & 31, hi = lane >> 5, kvh = head >> 2;
    const bf16* Qb = (const bf16*)(F.ws + WS_Q); bf16* Ob = (bf16*)(F.ws + WS_Q); const bf16* KX = (const bf16*)(F.ws + WS_KX);
    int r0, nkb; const bf16* kbase; const bf16* vtb; size_t vstr;
    if (ck < 256) { const int b = ck >> 7, n = ck & 127, n0 = n >= 2 ? n - 2 : 0; r0 = b * SEQ + 64 * n; nkb = 2 * (n - n0 + 1);
        kbase = KX + (size_t)(b * SEQ + 64 * n0) * 128 + kvh * 64; vtb = (const bf16*)(F.ws + WS_VTP) + (size_t)((b * 2 + kvh) * 64) * SEQ + 64 * n0; vstr = SEQ; }
    else { const int sb = ck - 256; r0 = MP + 64 * sb; nkb = 6; kbase = KX + (size_t)(MP + sb * 192) * 128 + kvh * 64; vtb = (const bf16*)(F.ws + WS_VTS) + (size_t)((sb * 2 + kvh) * 64) * 192; vstr = 192; }
    const float sink = INP(28)[head] * 1.4426950408889634f;
#pragma unroll 1
    for (int qb = 0; qb < 2; ++qb) {
        bf16x8 qf[4];
        const bf16* qrow = Qb + (size_t)(r0 + 32 * qb + l31) * 512 + head * 64 + 8 * hi;
#pragma unroll
        for (int s = 0; s < 4; ++s) qf[s] = *(const bf16x8*)(qrow + 16 * s);
        f32x16 S[6];
#pragma unroll
        for (int kb = 0; kb < 6; ++kb) {
            if (kb < nkb) {
                const bf16* krow = kbase + (size_t)(32 * kb + l31) * 128 + 8 * hi;
                f32x16 a = {0.f, 0.f, 0.f, 0.f, 0.f, 0.f, 0.f, 0.f, 0.f, 0.f, 0.f, 0.f, 0.f, 0.f, 0.f, 0.f};
#pragma unroll
                for (int s = 0; s < 4; ++s) { const bf16x8 kf = *(const bf16x8*)(krow + 16 * s); a = __builtin_amdgcn_mfma_f32_32x32x16_bf16(kf, qf[s], a, 0, 0, 0); }
                S[kb] = a;
            } else {
#pragma unroll
                for (int r = 0; r < 16; ++r) S[kb][r] = -1e30f;
            }
        }
        float mx = sink;
#pragma unroll
        for (int kb = 0; kb < 6; ++kb)
#pragma unroll
            for (int r = 0; r < 16; ++r) mx = fmaxf(mx, S[kb][r]);
        mx = fmaxf(mx, __shfl_xor(mx, 32));
        float lsum = 0.f;
#pragma unroll
        for (int kb = 0; kb < 6; ++kb)
#pragma unroll
            for (int r = 0; r < 16; ++r) { const float e = __builtin_amdgcn_exp2f(S[kb][r] - mx); S[kb][r] = e; lsum += e; }
        lsum += __shfl_xor(lsum, 32);
        lsum += __builtin_amdgcn_exp2f(sink - mx);
        const float rl = 1.0f / lsum;
        f32x16 o[2];
#pragma unroll
        for (int db = 0; db < 2; ++db)
#pragma unroll
            for (int r = 0; r < 16; ++r) o[db][r] = 0.f;
#pragma unroll
        for (int kb = 0; kb < 6; ++kb) {
            if (kb < nkb) {
#pragma unroll
                for (int s = 0; s < 2; ++s) {
                    u32x4q pw; pw.x = pg8::cvt_pk_bf16(S[kb][8 * s + 0], S[kb][8 * s + 1]); pw.y = pg8::cvt_pk_bf16(S[kb][8 * s + 2], S[kb][8 * s + 3]);
                    pw.z = pg8::cvt_pk_bf16(S[kb][8 * s + 4], S[kb][8 * s + 5]); pw.w = pg8::cvt_pk_bf16(S[kb][8 * s + 6], S[kb][8 * s + 7]);
                    const bf16x8 pf = __builtin_bit_cast(bf16x8, pw);
#pragma unroll
                    for (int db = 0; db < 2; ++db) {
                        const bf16* vp = vtb + (size_t)(32 * db + l31) * vstr + 32 * kb + 16 * s + 4 * hi;
                        const u32x2q v0 = *(const u32x2q*)vp, v1 = *(const u32x2q*)(vp + 8);
                        u32x4q vw; vw.x = v0.x; vw.y = v0.y; vw.z = v1.x; vw.w = v1.y;
                        o[db] = __builtin_amdgcn_mfma_f32_32x32x16_bf16(__builtin_bit_cast(bf16x8, vw), pf, o[db], 0, 0, 0);
                    }
                }
            }
        }
        bf16* orow = Ob + (size_t)(r0 + 32 * qb + l31) * 512 + head * 64;
#pragma unroll
        for (int db = 0; db < 2; ++db)
#pragma unroll
            for (int g4 = 0; g4 < 4; ++g4) { u32x2q w; w.x = pg8::cvt_pk_bf16(o[db][4 * g4 + 0] * rl, o[db][4 * g4 + 1] * rl); w.y = pg8::cvt_pk_bf16(o[db][4 * g4 + 2] * rl, o[db][4 * g4 + 3] * rl);
                *(u32x2q*)(orow + 32 * db + 8 * g4 + 4 * hi) = w; }
    }
}

constexpr int NPH = 15;
__global__ void __launch_bounds__(NWAVES * 64, 2) mk_fwd(Args args) {
    extern __shared__ __attribute__((aligned(16))) unsigned char lds[];
    Frame F;
    F.lds = (LAS unsigned char*)lds; F.MISC = (volatile LAS unsigned*)(F.lds + MISC_OFF);
    F.tid = threadIdx.x; F.lane = F.tid & 63; F.wave = __builtin_amdgcn_readfirstlane(F.tid >> 6);
    F.G = gridDim.x; { const int bx = blockIdx.x; F.vcu = (F.G % 8 == 0) ? (bx % 8) * (F.G / 8) + bx / 8 : bx; }
    F.ap = (KArgs)__builtin_amdgcn_kernarg_segment_ptr();
    F.out = args.out; F.ws = args.ws; F.ctl = (gu32*)(args.ws + WS_CTL);
    for (int u = F.tid; u < (LDS_BYTES - LDSCTL_OFF) / 4; u += NWAVES * 64) ((LAS unsigned*)(F.lds + LDSCTL_OFF))[u] = 0u;
    __syncthreads();
    XcdBarrier bar; bar.bar = (unsigned*)(F.ctl + CW_BAR); bar.x = 0; bar.st = nullptr;
    if (MK_SINGLE) bar = xcd_barrier_post((unsigned*)(F.ctl + CW_BAR), F.MISC + 8);
    const int lo = args.ph_lo, hi = args.ph_hi;
#define IN(k) (lo <= (k) && (k) < hi)
#define SEAM(k) do { if (IN(k) && IN((k) + 1)) xcd_barrier(bar); } while (0)
    unsigned char* ws = args.ws;
    const float* mod = (const float*)(ws + WS_MOD);

    if (IN(0)) { LAUNDER_ARGS(); p0_prologue(F); } SEAM(0);
    if (IN(1)) { LAUNDER_ARGS(); modulate_pass(F, 0, true, INP(10)); } SEAM(1);
    if (IN(2)) { LAUNDER_ARGS();
        pg8::Gemm g{(const pg8::bf16_t*)(ws + WS_XN), (const pg8::bf16_t*)(ws + WS_W1I), M, 2 * FF, DM}; pg8::StaticOrder S; S.init(M, 2 * FF, F.G, (int)blockIdx.x);
        pg8::EpiSwiglu E{(pg8::bf16_t*)(ws + WS_A), FF};
        pg8::gemm_phase<pg8::EpiSwiglu, pg8::StaticOrder, true, true>(F.lds + RING_OFF, g, S, E);
    } SEAM(2);
    if (IN(3)) { LAUNDER_ARGS();
        pg8::Gemm g{(const pg8::bf16_t*)(ws + WS_A), (const pg8::bf16_t*)(ws + WS_W1O), M, DM, FF}; pg8::StaticOrder S; S.init(M, DM, F.G, (int)blockIdx.x);
        pg8::EpiResid E{INP(0), INP(1), F.out, mod + 2 * DM, 0.5f, 1};
        pg8::gemm_phase<pg8::EpiResid, pg8::StaticOrder, true, true>(F.lds + RING_OFF, g, S, E);
    } SEAM(3);
    if (IN(4)) { LAUNDER_ARGS(); modulate_pass(F, 1, false, INP(13)); cache_convert(F); } SEAM(4);
    if (IN(5)) { LAUNDER_ARGS();
        pg8::Gemm g{(const pg8::bf16_t*)(ws + WS_XN), (const pg8::bf16_t*)(ws + WS_WIN), M, INW, DM}; pg8::StaticOrder S; S.init(M, INW, F.G, (int)blockIdx.x);
        pg8::EpiWin E{(pg8::bf16_t*)(ws + WS_S5U), (pg8::bf16_t*)(ws + WS_Q), (pg8::bf16_t*)(ws + WS_KX), (pg8::bf16_t*)(ws + WS_VTP), (pg8::bf16_t*)(ws + WS_VTS), (pg8::bf16_t*)(ws + WS_GS5), (pg8::bf16_t*)(ws + WS_GATT),
                      INP(26), INP(27), (const float*)(ws + WS_ROPE), F.out, QSCALE};
        pg8::gemm_phase<pg8::EpiWin, pg8::StaticOrder, true, true>(F.lds + RING_OFF, g, S, E);
    } SEAM(5);
    if (IN(6)) { LAUNDER_ARGS();
        if (F.wave == 0 && F.vcu < 64) s5_naive_unit(F, F.vcu >> 5, F.vcu & 31);
        else if (F.wave == 1) s5_naive_unit(F, NB + (F.vcu >> 5), F.vcu & 31);
        const int gw = F.vcu * NWAVES + F.wave, NGW = F.G * NWAVES;
        for (int uu = gw; uu < 264 * 8; uu += NGW) attn_wave_unit(F, uu >> 3, uu & 7);
    } SEAM(6);
    if (IN(7)) { LAUNDER_ARGS();
        pg8::Gemm g{(const pg8::bf16_t*)(ws + WS_YS5), (const pg8::bf16_t*)(ws + WS_WGLU), M, 512, 512}; pg8::StaticOrder S; S.init(M, 512, F.G, (int)blockIdx.x);
        pg8::EpiMix<0> E{(pg8::bf16_t*)(ws + WS_Y2), (const pg8::bf16_t*)(ws + WS_YS5), INP(24), 512};
        pg8::gemm_phase<pg8::EpiMix<0>, pg8::StaticOrder, true, true>(F.lds + RING_OFF, g, S, E);
    } SEAM(7);
    if (IN(8)) { LAUNDER_ARGS();
        pg8::Gemm g{(const pg8::bf16_t*)(ws + WS_Y2), (const pg8::bf16_t*)(ws + WS_WS5P), M, DM, 512}; pg8::StaticOrder S; S.init(M, DM, F.G, (int)blockIdx.x);
        pg8::EpiMix<1> E{(pg8::bf16_t*)(ws + WS_GS5), nullptr, nullptr, DM};
        pg8::gemm_phase<pg8::EpiMix<1>, pg8::StaticOrder, true, true>(F.lds + RING_OFF, g, S, E);
    } SEAM(8);
    if (IN(9)) { LAUNDER_ARGS();
        pg8::Gemm g{(const pg8::bf16_t*)(ws + WS_Q), (const pg8::bf16_t*)(ws + WS_WAP), M, DM, 512}; pg8::StaticOrder S; S.init(M, DM, F.G, (int)blockIdx.x);
        pg8::EpiMix<2> E{(pg8::bf16_t*)(ws + WS_GS5), (const pg8::bf16_t*)(ws + WS_GATT), nullptr, DM};
        pg8::gemm_phase<pg8::EpiMix<2>, pg8::StaticOrder, true, true>(F.lds + RING_OFF, g, S, E);
    } SEAM(9);
    if (IN(10)) { LAUNDER_ARGS();
        pg8::Gemm g{(const pg8::bf16_t*)(ws + WS_GS5), (const pg8::bf16_t*)(ws + WS_WOUT), M, DM, DM}; pg8::StaticOrder S; S.init(M, DM, F.G, (int)blockIdx.x);
        pg8::EpiResid E{INP(0), INP(1), F.out, mod + 5 * DM, 1.0f, 0};
        pg8::gemm_phase<pg8::EpiResid, pg8::StaticOrder, true, true>(F.lds + RING_OFF, g, S, E);
    } SEAM(10);
    if (IN(11)) { LAUNDER_ARGS(); modulate_pass(F, 2, false, INP(31)); } SEAM(11);
    if (IN(12)) { LAUNDER_ARGS();
        pg8::Gemm g{(const pg8::bf16_t*)(ws + WS_XN), (const pg8::bf16_t*)(ws + WS_W2I), M, 2 * FF, DM}; pg8::StaticOrder S; S.init(M, 2 * FF, F.G, (int)blockIdx.x);
        pg8::EpiSwiglu E{(pg8::bf16_t*)(ws + WS_A), FF};
        pg8::gemm_phase<pg8::EpiSwiglu, pg8::StaticOrder, true, true>(F.lds + RING_OFF, g, S, E);
    } SEAM(12);
    if (IN(13)) { LAUNDER_ARGS();
        pg8::Gemm g{(const pg8::bf16_t*)(ws + WS_A), (const pg8::bf16_t*)(ws + WS_W2O), M, DM, FF}; pg8::StaticOrder S; S.init(M, DM, F.G, (int)blockIdx.x);
        pg8::EpiResid E{INP(0), INP(1), F.out, mod + 8 * DM, 0.5f, 0};
        pg8::gemm_phase<pg8::EpiResid, pg8::StaticOrder, true, true>(F.lds + RING_OFF, g, S, E);
    } SEAM(13);
    if (IN(14)) { LAUNDER_ARGS(); final_norm_pass(F); }
#undef IN
#undef SEAM
}

extern "C" void kernel_launch(void* const* d_in, const int* in_sizes, int n_in, void* d_out, int out_size, void* d_ws, size_t ws_size, hipStream_t stream) {
    static int grid = 0;
    if (grid == 0) {
        if (n_in != 35 || in_sizes[0] != MP * DM || (size_t)out_size != O_END || ws_size < WS_END) { fprintf(stderr, "kernel_launch: unexpected shapes: n_in %d in0 %d out %d ws %zu\n", n_in, n_in > 0 ? in_sizes[0] : -1, out_size, ws_size); grid = -1; return; }
        int dev = 0, cus = 0;
        if (hipGetDevice(&dev) != hipSuccess || hipDeviceGetAttribute(&cus, hipDeviceAttributeMultiprocessorCount, dev) != hipSuccess) { grid = -1; return; }
        if (hipFuncSetAttribute((const void*)mk_fwd, hipFuncAttributeMaxDynamicSharedMemorySize, LDS_BYTES) != hipSuccess) { fprintf(stderr, "kernel_launch: hipFuncSetAttribute failed\n"); grid = -1; return; }
        (void)hipGetLastError();
        grid = cus;
    }
    if (grid < 0) return;
    if (hipMemsetAsync((char*)d_ws + WS_CTL, 0, CTL_ZERO_BYTES, stream) != hipSuccess) return;
    Args a{};
    for (int i = 0; i < 35; ++i) a.in[i] = (const float*)d_in[i];
    a.out = (float*)d_out; a.ws = (unsigned char*)d_ws;
    if (MK_SINGLE) { a.ph_lo = 0; a.ph_hi = NPH; a.li = 0; hipLaunchKernelGGL(mk_fwd, dim3(grid), dim3(NWAVES * 64), LDS_BYTES, stream, a); }
    else for (int ph = 0; ph < NPH; ++ph) { a.ph_lo = ph; a.ph_hi = ph + 1; a.li = 0; hipLaunchKernelGGL(mk_fwd, dim3(grid), dim3(NWAVES * 64), LDS_BYTES, stream, a); }
}
```

```cpp
#include <hip/hip_runtime.h>
#include <cstdio>
#include <cstdint>
namespace pg8 {
#define PG8_LAS __attribute__((address_space(3)))
typedef unsigned short bf16_t;
typedef short bf16x8 __attribute__((ext_vector_type(8)));
typedef float f32x4 __attribute__((ext_vector_type(4)));
typedef unsigned u32x4 __attribute__((ext_vector_type(4)));
constexpr int BM = 256, BK = 64, HALF = 128, HTB = HALF * BK * 2  , STAGE_BYTES = 8 * HTB, NXCD = 8, WGM = 4;

__host__ __device__ __forceinline__ int lds_byte(int r, int c) { const int st = (r >> 4) * 2 + (c >> 5), rr = r & 15, cc = c & 31, ob = rr * 64 + cc * 2; return st * 1024 + (ob ^ (((ob >> 9) & 1) << 5)); }
__host__ __device__ __forceinline__ void stage_rc(int b, int& R, int& C) { const int st = b / 1024, sb = b % 1024, swz = sb ^ (((sb >> 9) & 1) << 5); R = (st >> 1) * 16 + swz / 64; C = (st & 1) * 32 + (swz % 64) / 2; }
__host__ __device__ __forceinline__ int perm32(int rho) { const int n = rho >> 4, i = rho & 15; return 8 * (i >> 2) + 4 * n + (i & 3); }

struct Unit { int pm, pn, seg; };
struct Gemm { const bf16_t* A; const bf16_t* Bt; int M, N, K; const bf16_t* A2; const bf16_t* Bt2; };

struct StaticOrder {
    int nM, nN, nwg, G, c;
    __host__ __device__ void init(int M, int N, int G_, int c_) { nM = M / BM; nN = N / BM; nwg = nM * nN; G = G_; c = c_; }
    __host__ __device__ bool next(int i, Unit& u) const {
        const long L = (long)i * G + c; if (L >= nwg) return false;
        int wgid = (int)L; { const int q = nwg / NXCD, r = nwg % NXCD, xcd = wgid % NXCD, off = wgid / NXCD; wgid = (xcd < r ? xcd * (q + 1) : r * (q + 1) + (xcd - r) * q) + off; }
        const int nig = WGM * nN, gid = wgid / nig, fm = gid * WGM, gsz = (nM - fm) < WGM ? (nM - fm) : WGM;
        u.pm = fm + ((wgid % nig) % gsz); u.pn = (wgid % nig) / gsz; u.seg = 0; return true;
    }
    __device__ __forceinline__ void a_ready(const Unit&) const {}
    __device__ __forceinline__ void done(const Unit&) const {}
};
__device__ __forceinline__ unsigned cvt_pk_bf16(float lo, float hi) { unsigned r; asm volatile("s_nop 0\n\tv_cvt_pk_bf16_f32 %0, %1, %2" : "=v"(r) : "v"(lo), "v"(hi)); return r; }
typedef float f32x2 __attribute__((ext_vector_type(2)));
constexpr int R_MP = 16384, R_M = 16896;
__device__ __forceinline__ float bf_lo(unsigned w) { return __uint_as_float(w << 16); }
__device__ __forceinline__ float bf_hi(unsigned w) { return __uint_as_float(w & 0xffff0000u); }
__device__ __forceinline__ float fast_sigmoid(float x) { return __builtin_amdgcn_rcpf(1.0f + __builtin_amdgcn_exp2f(-1.4426950408889634f * x)); }
__device__ __forceinline__ f32x4 vsigmoid(const f32x4 x) {
    const f32x4 t = x * -1.4426950408889634f; f32x4 e;
#pragma unroll
    for (int j = 0; j < 4; ++j) e[j] = __builtin_amdgcn_exp2f(t[j]);
    const f32x4 d = e + 1.0f; f32x4 r;
#pragma unroll
    for (int j = 0; j < 4; ++j) r[j] = __builtin_amdgcn_rcpf(d[j]);
    return r;
}
__device__ __forceinline__ u32x4 pack8(const f32x4 a, const f32x4 b) { u32x4 w; w.x = cvt_pk_bf16(a[0], a[1]); w.y = cvt_pk_bf16(a[2], a[3]); w.z = cvt_pk_bf16(b[0], b[1]); w.w = cvt_pk_bf16(b[2], b[3]); return w; }
__device__ __forceinline__ void unpack8(const u32x4 w, f32x4& a, f32x4& b) { a = (f32x4){bf_lo(w.x), bf_hi(w.x), bf_lo(w.y), bf_hi(w.y)}; b = (f32x4){bf_lo(w.z), bf_hi(w.z), bf_lo(w.w), bf_hi(w.w)}; }

struct EpiSwiglu {
    static constexpr bool PERM = true, AFTER_DRAIN = false, CHAIN = false, XTRA = false;
    bf16_t* O; int ldo;
    __device__ __forceinline__ void operator()(const f32x4 (&acc)[2][2][4][2], const Unit& u, int wr, int wc, int fr, int fq) const {
        const int row0 = u.pm * BM + wr * 64 + fr, col0 = u.pn * HALF + wc * 32 + 8 * fq;
#pragma unroll
        for (int ai = 0; ai < 2; ++ai)
#pragma unroll
            for (int m = 0; m < 4; ++m) {
                f32x4 o[2];
#pragma unroll
                for (int n = 0; n < 2; ++n) { const f32x4 a = acc[ai][0][m][n], b = acc[ai][1][m][n]; o[n] = a * vsigmoid(a) * b; }
                *(u32x4*)(O + (size_t)(row0 + ai * HALF + m * 16) * ldo + col0) = pack8(o[0], o[1]);
            }
    }
};

template <int FROM_X> struct EpiResid {
    static constexpr bool PERM = false, AFTER_DRAIN = false, CHAIN = false, XTRA = false;
    const float* xp; const float* xs; bf16_t* Hb; const float* gate;
    float scale; bf16_t* XN;
    typedef unsigned u32x2e __attribute__((ext_vector_type(2)));
    __device__ __forceinline__ void operator()(const f32x4 (&acc)[2][2][4][2], const Unit& u, int wr, int wc, int fr, int fq) const {
        const int col0 = u.pn * BM + wc * 32 + 4 * fq;
        bf16_t* outp = XN ? XN : Hb;
#pragma unroll
        for (int ai = 0; ai < 2; ++ai) {
            const int s = u.pm < 64 ? (u.pm >> 5) : 2 + (u.pm - 64) * 4 + ai * 2 + wr;
            f32x4 g[2][2];
#pragma unroll
            for (int bj = 0; bj < 2; ++bj)
#pragma unroll
                for (int n = 0; n < 2; ++n) g[bj][n] = *(const f32x4*)(gate + (size_t)s * 9216 + col0 + bj * HALF + n * 16) * scale;
#pragma unroll
            for (int mp = 0; mp < 2; ++mp) {
                f32x4 b[2][2][2];
#pragma unroll
                for (int mm = 0; mm < 2; ++mm) { const int r = u.pm * BM + ai * HALF + wr * 64 + (2 * mp + mm) * 16 + fr;
#pragma unroll
                    for (int bj = 0; bj < 2; ++bj)
#pragma unroll
                        for (int n = 0; n < 2; ++n) { const int c = col0 + bj * HALF + n * 16;
                            if (FROM_X) b[mm][bj][n] = *(const f32x4*)((r < R_MP ? xp + (size_t)r * 1024 : xs + (size_t)(r - R_MP) * 1024) + c);
                            else { const u32x2e w = *(const u32x2e*)(Hb + (size_t)r * 1024 + c); b[mm][bj][n] = (f32x4){bf_lo(w.x), bf_hi(w.x), bf_lo(w.y), bf_hi(w.y)}; } } }
                asm volatile("" ::: "memory");
#pragma unroll
                for (int mm = 0; mm < 2; ++mm) { const int m = 2 * mp + mm; const int r = u.pm * BM + ai * HALF + wr * 64 + m * 16 + fr;
#pragma unroll
                    for (int bj = 0; bj < 2; ++bj)
#pragma unroll
                        for (int n = 0; n < 2; ++n) { const f32x4 h = b[mm][bj][n] + g[bj][n] * acc[ai][bj][m][n];
                            u32x2e w; w.x = cvt_pk_bf16(h[0], h[1]); w.y = cvt_pk_bf16(h[2], h[3]); *(u32x2e*)(outp + (size_t)r * 1024 + col0 + bj * HALF + n * 16) = w; } }
                asm volatile("" ::: "memory");
            }
        }
    }
};

typedef __attribute__((address_space(1))) unsigned pgu32;
__device__ __forceinline__ void nrm_wait(pgu32* cnt, unsigned want, pgu32* tmo) {
    unsigned sp = 0;
    while ((unsigned)__builtin_amdgcn_readfirstlane(__hip_atomic_load(cnt, __ATOMIC_RELAXED, __HIP_MEMORY_SCOPE_AGENT)) != want) {
        __builtin_amdgcn_s_sleep(1);
        if ((++sp & 255u) == 0u) { if (__hip_atomic_load(tmo, __ATOMIC_RELAXED, __HIP_MEMORY_SCOPE_AGENT)) break; if (sp > (1u << 18)) { __hip_atomic_fetch_add(tmo, 1u, __ATOMIC_RELAXED, __HIP_MEMORY_SCOPE_AGENT); break; } }
    }
}
template <int FROM_X, int FINAL> struct EpiResidNorm {
    static constexpr bool PERM = true, AFTER_DRAIN = true, CHAIN = false, XTRA = true;
    const float* xp; const float* xs; const bf16_t* Hin; bf16_t* Hout; const float* gate;
    const float* gnorm; const float* msh;
    bf16_t* XN; float* Y;
    float* part; unsigned* cnt; unsigned* tmo;
    const bf16_t* XA;
    float scale; unsigned want;
    __device__ __forceinline__ const bf16_t* xrows(const Unit& u, int K) const { return XA + (size_t)(R_MP + 8 * u.pm) * K; }
    __device__ __forceinline__ void operator()(const f32x4 (&)[2][2][4][2], const Unit&, int, int, int, int) const {}
    __device__ __forceinline__ void fused(f32x4 (&acc)[2][2][4][2], f32x4 (&xacc)[2], const Unit& u, int wr, int wc, int, int, PG8_LAS unsigned char* lds, int wid, int) const {
        int tid = threadIdx.x; asm volatile("" : "+v"(tid));
        const int fr = tid & 15, fq = (tid >> 4) & 3;
        const int s = u.pm >> 5, col0 = u.pn * BM + wc * 32 + 8 * fq, rowb = u.pm * BM + wr * 64 + fr;
        const int sx = 2 + (u.pm >> 3), colx = col0 + wr * HALF, rowx = R_MP + 8 * u.pm + (fr & 7); const bool vx = fr < 8;
        PG8_LAS float* red = (PG8_LAS float*)lds;
        float ss[2][4];
        {
            f32x4 g[2][2];
#pragma unroll
            for (int bj = 0; bj < 2; ++bj)
#pragma unroll
                for (int n = 0; n < 2; ++n) g[bj][n] = *(const f32x4*)(gate + (size_t)s * 9216 + col0 + bj * HALF + n * 4) * scale;
#pragma unroll
            for (int ai = 0; ai < 2; ++ai)
#pragma unroll
                for (int mp = 0; mp < 2; ++mp) {
                    f32x4 b[2][2][2];
#pragma unroll
                    for (int mm = 0; mm < 2; ++mm) { const int r = rowb + ai * HALF + (2 * mp + mm) * 16;
#pragma unroll
                        for (int bj = 0; bj < 2; ++bj) { const int c = col0 + bj * HALF;
                            if (FROM_X) { b[mm][bj][0] = *(const f32x4*)(xp + (size_t)r * 1024 + c); b[mm][bj][1] = *(const f32x4*)(xp + (size_t)r * 1024 + c + 4); }
                            else unpack8(*(const u32x4*)(Hin + (size_t)r * 1024 + c), b[mm][bj][0], b[mm][bj][1]); } }
                    asm volatile("" ::: "memory");
#pragma unroll
                    for (int mm = 0; mm < 2; ++mm) { const int m = 2 * mp + mm; float a = 0.f;
#pragma unroll
                        for (int bj = 0; bj < 2; ++bj)
#pragma unroll
                            for (int n = 0; n < 2; ++n) { const f32x4 h = b[mm][bj][n] + g[bj][n] * acc[ai][bj][m][n]; acc[ai][bj][m][n] = h; a += (h[0] * h[0] + h[1] * h[1]) + (h[2] * h[2] + h[3] * h[3]); }
                        ss[ai][m] = a; }
                    asm volatile("" :: "v"(ss[ai][2 * mp]), "v"(ss[ai][2 * mp + 1]) : "memory");
                }
        }
        {
            f32x4 b0, b1;
            if (FROM_X) { b0 = *(const f32x4*)(xs + (size_t)(rowx - R_MP) * 1024 + colx); b1 = *(const f32x4*)(xs + (size_t)(rowx - R_MP) * 1024 + colx + 4); }
            else unpack8(*(const u32x4*)(Hin + (size_t)rowx * 1024 + colx), b0, b1);
            const f32x4 g0 = *(const f32x4*)(gate + (size_t)sx * 9216 + colx) * scale, g1 = *(const f32x4*)(gate + (size_t)sx * 9216 + colx + 4) * scale;
            const f32x4 h0 = b0 + g0 * xacc[0], h1 = b1 + g1 * xacc[1]; xacc[0] = h0; xacc[1] = h1;
            float a = ((h0[0] * h0[0] + h0[1] * h0[1]) + (h0[2] * h0[2] + h0[3] * h0[3])) + ((h1[0] * h1[0] + h1[1] * h1[1]) + (h1[2] * h1[2] + h1[3] * h1[3]));
            a += __shfl_xor(a, 16); a += __shfl_xor(a, 32); if (fq == 0 && vx) red[1344 + wid * 8 + fr] = a;
        }
#pragma unroll
        for (int ai = 0; ai < 2; ++ai)
#pragma unroll
            for (int m = 0; m < 4; ++m) { float a = ss[ai][m]; a += __shfl_xor(a, 16); a += __shfl_xor(a, 32); if (fq == 0) red[wc * 256 + ai * HALF + wr * 64 + m * 16 + fr] = a; }
        __syncthreads();
        if (tid < 264) { float p;
            if (tid < 256) p = (red[tid] + red[256 + tid]) + (red[512 + tid] + red[768 + tid]);
            else { p = 0.f;
#pragma unroll
                for (int w8 = 0; w8 < 8; ++w8) p += red[1344 + w8 * 8 + (tid - 256)]; }
            __hip_atomic_store((pgu32*)(part + (size_t)(u.pm * 4 + u.pn) * 264 + tid), __float_as_uint(p), __ATOMIC_RELAXED, __HIP_MEMORY_SCOPE_AGENT); }
        asm volatile("s_waitcnt vmcnt(0)" ::: "memory");
        __syncthreads();
        if (tid == 0) (void)__hip_atomic_fetch_add((pgu32*)(cnt + u.pm * 16), 1u, __ATOMIC_RELAXED, __HIP_MEMORY_SCOPE_AGENT);
        if (!FINAL) {
#pragma unroll
            for (int ai = 0; ai < 2; ++ai)
#pragma unroll
                for (int m = 0; m < 4; ++m)
#pragma unroll
                    for (int bj = 0; bj < 2; ++bj) *(u32x4*)(Hout + (size_t)(rowb + ai * HALF + m * 16) * 1024 + col0 + bj * HALF) = pack8(acc[ai][bj][m][0], acc[ai][bj][m][1]);
            if (vx) *(u32x4*)(Hout + (size_t)rowx * 1024 + colx) = pack8(xacc[0], xacc[1]);
        }
        f32x4 ga[2][2], sh[2][2];
#pragma unroll
        for (int bj = 0; bj < 2; ++bj)
#pragma unroll
            for (int n = 0; n < 2; ++n) { const int c = col0 + bj * HALF + n * 4; ga[bj][n] = *(const f32x4*)(gnorm + c);
                if (!FINAL) { ga[bj][n] = ga[bj][n] * (*(const f32x4*)(msh + (size_t)s * 9216 + 1024 + c) + 1.0f); sh[bj][n] = *(const f32x4*)(msh + (size_t)s * 9216 + c); } }
        if (wid == 0) nrm_wait((pgu32*)(cnt + u.pm * 16), want, (pgu32*)tmo);
        __syncthreads();
        if (tid < 264) { float t = 0.f;
#pragma unroll
            for (int j = 0; j < 4; ++j) t += __uint_as_float(__hip_atomic_load((pgu32*)(part + (size_t)(u.pm * 4 + j) * 264 + tid), __ATOMIC_RELAXED, __HIP_MEMORY_SCOPE_AGENT));
            red[1024 + tid] = 1.0f / sqrtf(t * (1.0f / 1024.0f) + 1e-6f); }
        __syncthreads();
#pragma unroll
        for (int ai = 0; ai < 2; ++ai)
#pragma unroll
            for (int m = 0; m < 4; ++m) { const int rl = ai * HALF + wr * 64 + m * 16 + fr; const float rs = red[1024 + rl]; const size_t ro = (size_t)(u.pm * BM + rl) * 1024 + col0;
#pragma unroll
                for (int bj = 0; bj < 2; ++bj) {
                    if (FINAL) { *(f32x4*)(Y + ro + bj * HALF) = acc[ai][bj][m][0] * rs * ga[bj][0]; *(f32x4*)(Y + ro + bj * HALF + 4) = acc[ai][bj][m][1] * rs * ga[bj][1]; }
                    else *(u32x4*)(XN + ro + bj * HALF) = pack8(acc[ai][bj][m][0] * rs * ga[bj][0] + sh[bj][0], acc[ai][bj][m][1] * rs * ga[bj][1] + sh[bj][1]); } }
        {
            const float rs = red[1024 + 256 + (fr & 7)]; const size_t ro = (size_t)rowx * 1024 + colx;
            f32x4 a0 = *(const f32x4*)(gnorm + colx), a1 = *(const f32x4*)(gnorm + colx + 4);
            if (FINAL) { if (vx) { *(f32x4*)(Y + ro) = xacc[0] * rs * a0; *(f32x4*)(Y + ro + 4) = xacc[1] * rs * a1; } }
            else { const float* mp_ = msh + (size_t)sx * 9216;
                a0 = a0 * (*(const f32x4*)(mp_ + 1024 + colx) + 1.0f); a1 = a1 * (*(const f32x4*)(mp_ + 1024 + colx + 4) + 1.0f);
                const f32x4 s0 = *(const f32x4*)(mp_ + colx), s1 = *(const f32x4*)(mp_ + colx + 4);
                if (vx) *(u32x4*)(XN + ro) = pack8(xacc[0] * rs * a0 + s0, xacc[1] * rs * a1 + s1); }
        }
    }
};

struct EpiWin {
    static constexpr bool PERM = true, AFTER_DRAIN = false, CHAIN = false, XTRA = false;
    bf16_t *S5U, *Q, *KX, *KXS, *VTP, *VTS, *GS5, *GATT;
    const float *qn, *kn, *rope;
    float* out;
    float qscale;
    __device__ __forceinline__ void operator()(const f32x4 (&acc)[2][2][4][2], const Unit& u, int wr, int wc, int fr_, int fq_) const {
        int fr = fr_, fq = fq_; asm volatile("" : "+v"(fr), "+v"(fq));
        const int pn = u.pn, rowt = u.pm * BM + wr * 64 + fr;
        if (pn < 2) {
#pragma unroll
            for (int ai = 0; ai < 2; ++ai)
#pragma unroll
                for (int m = 0; m < 4; ++m) { const int r = rowt + ai * HALF + m * 16, nchk = r >> 6, sp = r & 63;
#pragma unroll
                    for (int bj = 0; bj < 2; ++bj) { const int col = pn * 256 + bj * HALF + wc * 32 + 8 * fq, g = col >> 4, c0 = col & 15;
                        *(u32x4*)(S5U + ((size_t)((g * 264 + nchk) * 64 + sp) * 16 + c0)) = pack8(acc[ai][bj][m][0], acc[ai][bj][m][1]); } }
            return;
        }
        if (pn >= 5) {
            bf16_t* base; int ld, cb; bool sig;
            if (pn < 9) { base = GS5; ld = 1024; cb = (pn - 5) * 256; sig = true; }
            else { base = GATT; ld = 1024; cb = (pn - 9) * 256; sig = true; }
            const int col0 = cb + wc * 32 + 8 * fq;
#pragma unroll
            for (int ai = 0; ai < 2; ++ai)
#pragma unroll
                for (int m = 0; m < 4; ++m) { bf16_t* rowp = base + (size_t)(rowt + ai * HALF + m * 16) * ld + col0;
#pragma unroll
                    for (int bj = 0; bj < 2; ++bj) { f32x4 v0 = acc[ai][bj][m][0], v1 = acc[ai][bj][m][1];
                        if (sig) { v0 = vsigmoid(v0); v1 = vsigmoid(v1); }
                        *(u32x4*)(rowp + bj * HALF) = pack8(v0, v1); } }
            return;
        }
        const bool isv = (pn == 4) && (wc >= 2);
        if (!isv) {
            const bool isq = pn < 4;
            const int head = isq ? (pn - 2) * 4 + wc : wc;
            const float* gn = isq ? qn : kn;
            f32x4 gw[2][2];
#pragma unroll
            for (int bj = 0; bj < 2; ++bj)
#pragma unroll
                for (int n = 0; n < 2; ++n) gw[bj][n] = *(const f32x4*)(gn + 32 * bj + 8 * fq + 4 * n);
#pragma unroll
            for (int ai = 0; ai < 2; ++ai)
#pragma unroll
                for (int m = 0; m < 4; ++m) {
                    const int r = rowt + ai * HALF + m * 16;
                    const int pos = r < R_MP ? (r & 8191) : 2048 + ((r - R_MP) & 63);
                    float ss = 0.f;
#pragma unroll
                    for (int bj = 0; bj < 2; ++bj)
#pragma unroll
                        for (int n = 0; n < 2; ++n) { const f32x4 x = acc[ai][bj][m][n]; ss += (x[0] * x[0] + x[1] * x[1]) + (x[2] * x[2] + x[3] * x[3]); }
                    ss += __shfl_xor(ss, 16); ss += __shfl_xor(ss, 32);
                    const float rn = 1.0f / sqrtf(ss * (1.0f / 64.0f) + 1e-6f);
                    f32x4 v[2][2];
#pragma unroll
                    for (int bj = 0; bj < 2; ++bj)
#pragma unroll
                        for (int n = 0; n < 2; ++n) v[bj][n] = acc[ai][bj][m][n] * rn * gw[bj][n];
#pragma unroll
                    for (int n = 0; n < 2; ++n) {
                        const f32x4 cs = *(const f32x4*)(rope + (size_t)pos * 16 + 4 * n), sn = *(const f32x4*)(rope + (size_t)pos * 16 + 8 + 4 * n);
                        f32x4 pr;
#pragma unroll
                        for (int j = 0; j < 4; ++j) pr[j] = __shfl_xor(v[0][n][j], 16);
                        if (fq == 0) v[0][n] = v[0][n] * cs - pr * sn;
                        else if (fq == 1) v[0][n] = v[0][n] * cs + pr * sn;
                    }
                    if (isq) {
                        bf16_t* rowp = Q + (size_t)r * 512 + head * 64 + 8 * fq;
#pragma unroll
                        for (int bj = 0; bj < 2; ++bj) *(u32x4*)(rowp + 32 * bj) = pack8(v[bj][0] * qscale, v[bj][1] * qscale);
                    } else {
                        bf16_t* rowp = (r < R_MP ? KX + (size_t)r * 128 : KXS + (size_t)(((r - R_MP) >> 6) * 192 + 128 + ((r - R_MP) & 63)) * 128) + head * 64 + 8 * fq;
#pragma unroll
                        for (int bj = 0; bj < 2; ++bj) *(u32x4*)(rowp + 32 * bj) = pack8(v[bj][0], v[bj][1]);
                        float* wp = nullptr;
                        if (r < R_MP) { if (pos >= 8064) wp = out + 17301504 + (size_t)(((r >> 13) * 128 + (pos - 8064)) * 2 + head) * 64; }
                        else wp = out + 17375232 + (size_t)((((r - R_MP) >> 6) * 128 + 64 + ((r - R_MP) & 63)) * 2 + head) * 64;
                        if (wp) {
#pragma unroll
                            for (int bj = 0; bj < 2; ++bj)
#pragma unroll
                                for (int n = 0; n < 2; ++n) *(f32x4*)(wp + 32 * bj + 8 * fq + 4 * n) = v[bj][n];
                        }
                    }
                }
        } else {
            const int head = wc - 2;
#pragma unroll
            for (int ai = 0; ai < 2; ++ai)
#pragma unroll
                for (int m = 0; m < 4; ++m) {
                    const int r = rowt + ai * HALF + m * 16;
                    bf16_t* vt; size_t vstr; float* wp = nullptr;
                    if (r < R_MP) { const int b = r >> 13, pos = r & 8191; vt = VTP + (size_t)((b * 2 + head) * 64) * 8192 + pos; vstr = 8192;
                        if (pos >= 8064) wp = out + 17334272 + (size_t)((b * 128 + (pos - 8064)) * 2 + head) * 64; }
                    else { const int sb = (r - R_MP) >> 6, t = (r - R_MP) & 63; vt = VTS + (size_t)((sb * 2 + head) * 64) * 192 + 128 + t; vstr = 192;
                        wp = out + 17506304 + (size_t)((sb * 128 + 64 + t) * 2 + head) * 64; }
#pragma unroll
                    for (int bj = 0; bj < 2; ++bj)
#pragma unroll
                        for (int n = 0; n < 2; ++n) { const f32x4 x = acc[ai][bj][m][n]; const int d0 = 32 * bj + 8 * fq + 4 * n;
                            const unsigned w0 = cvt_pk_bf16(x[0], x[1]), w1 = cvt_pk_bf16(x[2], x[3]);
                            vt[(size_t)(d0 + 0) * vstr] = (bf16_t)(w0 & 0xffffu); vt[(size_t)(d0 + 1) * vstr] = (bf16_t)(w0 >> 16);
                            vt[(size_t)(d0 + 2) * vstr] = (bf16_t)(w1 & 0xffffu); vt[(size_t)(d0 + 3) * vstr] = (bf16_t)(w1 >> 16);
                            if (wp) *(f32x4*)(wp + d0) = x; }
                }
        }
    }
};

template <int MODE> struct EpiMix {
    static constexpr bool PERM = true, AFTER_DRAIN = false, CHAIN = false, XTRA = false;
    bf16_t* O; const bf16_t* Y; const float* bias; int ld;
    __device__ __forceinline__ void operator()(const f32x4 (&acc)[2][2][4][2], const Unit& u, int wr, int wc, int fr, int fq) const {
        const int row0 = u.pm * BM + wr * 64 + fr, col0 = u.pn * BM + wc * 32 + 8 * fq;
#pragma unroll
        for (int ai = 0; ai < 2; ++ai)
#pragma unroll
            for (int m = 0; m < 4; ++m) { const size_t off = (size_t)(row0 + ai * HALF + m * 16) * ld + col0;
#pragma unroll
                for (int bj = 0; bj < 2; ++bj) {
                    const f32x4 a0 = acc[ai][bj][m][0], a1 = acc[ai][bj][m][1]; f32x4 o0, o1;
                    if (MODE == 0) { f32x4 y0, y1; unpack8(*(const u32x4*)(Y + off + bj * HALF), y0, y1);
                        const f32x4 b0 = *(const f32x4*)(bias + col0 + bj * HALF), b1 = *(const f32x4*)(bias + col0 + bj * HALF + 4);
                        o0 = y0 * vsigmoid(a0 + b0); o1 = y1 * vsigmoid(a1 + b1); }
                    else if (MODE == 1) { f32x4 g0, g1; unpack8(*(const u32x4*)(O + off + bj * HALF), g0, g1); o0 = g0 * a0; o1 = g1 * a1; }
                    else { f32x4 t0, t1, g0, g1; unpack8(*(const u32x4*)(O + off + bj * HALF), t0, t1); unpack8(*(const u32x4*)(Y + off + bj * HALF), g0, g1); o0 = t0 + g0 * a0; o1 = t1 + g1 * a1; }
                    *(u32x4*)(O + off + bj * HALF) = pack8(o0, o1); } }
    }
};

struct EpiProj {
    static constexpr bool PERM = true, AFTER_DRAIN = false, CHAIN = true, XTRA = false;
    bf16_t* GS5; const bf16_t* GATT;
    __device__ __forceinline__ void mid(f32x4 (&acc)[2][2][4][2], const Unit& u, int wr, int wc, int fr, int fq) const {
        const int row0 = u.pm * BM + wr * 64 + fr, col0 = u.pn * BM + wc * 32 + 8 * fq;
#pragma unroll
        for (int ai = 0; ai < 2; ++ai)
#pragma unroll
            for (int m = 0; m < 4; ++m) { const size_t off = (size_t)(row0 + ai * HALF + m * 16) * 1024 + col0;
#pragma unroll
                for (int bj = 0; bj < 2; ++bj) { f32x4 s0, s1, a0, a1; unpack8(*(const u32x4*)(GS5 + off + bj * HALF), s0, s1); unpack8(*(const u32x4*)(GATT + off + bj * HALF), a0, a1);
#pragma unroll
                    for (int j = 0; j < 4; ++j) { s0[j] *= __builtin_amdgcn_rcpf(fmaxf(a0[j], 1e-30f)); s1[j] *= __builtin_amdgcn_rcpf(fmaxf(a1[j], 1e-30f)); }
                    acc[ai][bj][m][0] *= s0; acc[ai][bj][m][1] *= s1; } }
    }
    __device__ __forceinline__ void operator()(const f32x4 (&acc)[2][2][4][2], const Unit& u, int wr, int wc, int fr, int fq) const {
        const int row0 = u.pm * BM + wr * 64 + fr, col0 = u.pn * BM + wc * 32 + 8 * fq;
#pragma unroll
        for (int ai = 0; ai < 2; ++ai)
#pragma unroll
            for (int m = 0; m < 4; ++m) { const size_t off = (size_t)(row0 + ai * HALF + m * 16) * 1024 + col0;
#pragma unroll
                for (int bj = 0; bj < 2; ++bj) { f32x4 a0, a1; unpack8(*(const u32x4*)(GATT + off + bj * HALF), a0, a1);
                    *(u32x4*)(GS5 + off + bj * HALF) = pack8(a0 * acc[ai][bj][m][0], a1 * acc[ai][bj][m][1]); } }
    }
};
struct ChainOrder : StaticOrder {
    __host__ __device__ bool next(int i, Unit& u) const { if (!StaticOrder::next(i >> 1, u)) return false; u.seg = i & 1; return true; }
};
template <class Epi, class Sched, bool ALIGN_EPI = false, bool SP2 = false>
__device__ __forceinline__ void gemm_phase(PG8_LAS unsigned char* lds, const Gemm g, const Sched& S, const Epi& E) {
    const int tid = threadIdx.x, wid = __builtin_amdgcn_readfirstlane(tid >> 6), lane = tid & 63, wr = wid >> 2, wc = wid & 3, fr = lane & 15, fq = lane >> 4;
    const int K = g.K, nt = K / BK;
    unsigned voffA[2], voffB[2];
#pragma unroll
    for (int i = 0; i < 2; ++i) { int R, C; stage_rc(tid * 16 + i * 8192, R, C); const int Rb = Epi::PERM ? ((R & ~31) + perm32(R & 31)) : R;
        voffA[i] = (unsigned)(R * K + C) * 2u; voffB[i] = (unsigned)(Rb * K + C) * 2u; }
    const size_t kstep = (size_t)(BK * 2);
    const size_t hstep = (size_t)HALF * K * 2;
    const size_t tstep = 2 * hstep;
    const unsigned ldsw = (unsigned)wid * 1024u;
    const int aoff = lds_byte(wr * 64 + fr, fq * 8), boff = lds_byte(wc * 32 + fr, fq * 8);
#define PG8_SA(b, h) (((b) * 2 + (h)) * HTB)
#define PG8_SB(b, h) ((4 + (b) * 2 + (h)) * HTB)
#define PG8_STAGE(bufoff, gbase, voff) do { _Pragma("unroll") for (int _i = 0; _i < 2; ++_i) \
        __builtin_amdgcn_global_load_lds((const unsigned*)((const char*)(gbase) + (voff)[_i]), (PG8_LAS unsigned*)(lds + (bufoff) + ldsw + _i * 8192), 16, 0, 0); } while (0)
#define PG8_LDA(dst, b, h) do { _Pragma("unroll") for (int m = 0; m < 4; ++m) _Pragma("unroll") for (int k = 0; k < 2; ++k) dst[m][k] = *(const PG8_LAS bf16x8*)(lds + PG8_SA(b, h) + aoff + m * 2048 + k * 1024); } while (0)
#define PG8_LDB(dst, b, h) do { _Pragma("unroll") for (int n = 0; n < 2; ++n) _Pragma("unroll") for (int k = 0; k < 2; ++k) dst[n][k] = *(const PG8_LAS bf16x8*)(lds + PG8_SB(b, h) + boff + n * 2048 + k * 1024); } while (0)
#define PG8_MMA(ai, bj, At, Bt) do { __builtin_amdgcn_s_setprio(1); _Pragma("unroll") for (int m = 0; m < 4; ++m) _Pragma("unroll") for (int n = 0; n < 2; ++n) _Pragma("unroll") for (int k = 0; k < 2; ++k) \
        acc[ai][bj][m][n] = __builtin_amdgcn_mfma_f32_16x16x32_bf16(Bt[n][k], At[m][k], acc[ai][bj][m][n], 0, 0, 0); __builtin_amdgcn_s_setprio(0); } while (0)
#define PG8_WAIT_V(n) asm volatile("s_waitcnt vmcnt(" #n ")" ::: "memory")
#define PG8_WAIT_L(n) asm volatile("s_waitcnt lgkmcnt(" #n ")" ::: "memory")
#define PG8_BAR __builtin_amdgcn_s_barrier()
#define PG8_SCHED __builtin_amdgcn_sched_barrier(0)
    Unit cur, nxt; int ui = 0;
    if (!S.next(0, cur)) return;
    f32x4 acc[2][2][4][2];
#pragma unroll
    for (int a = 0; a < 2; ++a)
#pragma unroll
        for (int b = 0; b < 2; ++b)
#pragma unroll
            for (int m = 0; m < 4; ++m)
#pragma unroll
                for (int n = 0; n < 2; ++n) acc[a][b][m][n] = (f32x4){0.f, 0.f, 0.f, 0.f};
    bf16x8 At[4][2], B0[2][2], B1[2][2];
    constexpr int XOFF = STAGE_BYTES + 4096, XPITCH = 144, XBUF = 8 * XPITCH;
    [[maybe_unused]] f32x4 xacc[2]; [[maybe_unused]] bf16x8 xs[2]; [[maybe_unused]] const char* xg = nullptr;
#define PG8_XLOAD(tt) do { const int _t = (tt) < nt ? (tt) : nt - 1; if (lane < 8) __builtin_amdgcn_global_load_lds((const unsigned*)(xg + (size_t)_t * kstep), (PG8_LAS unsigned*)(lds + XOFF + (_t & 3) * XBUF + wid * XPITCH), 16, 0, 0); } while (0)
#define PG8_XLDS(tt) do { _Pragma("unroll") for (int k = 0; k < 2; ++k) xs[k] = *(const PG8_LAS bf16x8*)(lds + XOFF + ((tt) & 3) * XBUF + (fr & 7) * XPITCH + k * 64 + fq * 16); } while (0)
#define PG8_XMMA() do { if (wr == 0) { _Pragma("unroll") for (int n = 0; n < 2; ++n) _Pragma("unroll") for (int k = 0; k < 2; ++k) xacc[n] = __builtin_amdgcn_mfma_f32_16x16x32_bf16(B0[n][k], xs[k], xacc[n], 0, 0, 0); } \
        else { _Pragma("unroll") for (int n = 0; n < 2; ++n) _Pragma("unroll") for (int k = 0; k < 2; ++k) xacc[n] = __builtin_amdgcn_mfma_f32_16x16x32_bf16(B1[n][k], xs[k], xacc[n], 0, 0, 0); } } while (0)
    if constexpr (Epi::XTRA) { static_assert(SP2, "XTRA: SP2 loop only"); xacc[0] = (f32x4){0.f, 0.f, 0.f, 0.f}; xacc[1] = (f32x4){0.f, 0.f, 0.f, 0.f};
        xg = (const char*)E.xrows(cur, K) + ((size_t)wid * K + 8 * (lane & 7)) * 2; PG8_XLOAD(0); PG8_XLOAD(1); }
    const char* cA = (const char*)((Epi::CHAIN && cur.seg) ? g.A2 : g.A) + (size_t)cur.pm * tstep; const char* cB = (const char*)((Epi::CHAIN && cur.seg) ? g.Bt2 : g.Bt) + (size_t)cur.pn * tstep;
    S.a_ready(cur);
    if constexpr (SP2) {
        PG8_STAGE(PG8_SB(0, 0), cB, voffB); PG8_STAGE(PG8_SB(0, 1), cB + hstep, voffB); PG8_STAGE(PG8_SA(0, 0), cA, voffA); PG8_STAGE(PG8_SA(0, 1), cA + hstep, voffA);
        if (wr == 1) PG8_BAR;
        PG8_WAIT_V(2); PG8_BAR;
        PG8_STAGE(PG8_SB(1, 0), cB + kstep, voffB); PG8_STAGE(PG8_SA(1, 0), cA + kstep, voffA); PG8_STAGE(PG8_SB(1, 1), cB + hstep + kstep, voffB);
        PG8_WAIT_V(6); PG8_BAR;
    } else {
        PG8_STAGE(PG8_SB(0, 0), cB, voffB); PG8_STAGE(PG8_SA(0, 0), cA, voffA); PG8_STAGE(PG8_SB(0, 1), cB + hstep, voffB); PG8_STAGE(PG8_SA(0, 1), cA + hstep, voffA);
        if (wr == 1) PG8_BAR;
        PG8_WAIT_V(4); PG8_BAR;
        PG8_STAGE(PG8_SB(1, 0), cB + kstep, voffB); PG8_STAGE(PG8_SA(1, 0), cA + kstep, voffA); PG8_STAGE(PG8_SB(1, 1), cB + hstep + kstep, voffB);
        PG8_WAIT_V(6); PG8_BAR;
    }
    for (;;) {
        const bool has_next = S.next(ui + 1, nxt);
        const char* nA = has_next ? (const char*)((Epi::CHAIN && nxt.seg) ? g.A2 : g.A) + (size_t)nxt.pm * tstep : cA; const char* nB = has_next ? (const char*)((Epi::CHAIN && nxt.seg) ? g.Bt2 : g.Bt) + (size_t)nxt.pn * tstep : cB;
        for (int t = 0; t < nt; t += 2) {
            const bool last = (t == nt - 2);
            const char* a1 = cA + (size_t)(t + 1) * kstep;
            const char* a2 = last ? nA : cA + (size_t)(t + 2) * kstep; const char* b2 = last ? nB : cB + (size_t)(t + 2) * kstep;
            const char* a3 = a2 + kstep; const char* b3 = b2 + kstep;
            if (last && has_next) S.a_ready(nxt);
            if constexpr (SP2) {
            PG8_LDB(B0, 0, 0); PG8_LDB(B1, 0, 1); PG8_SCHED; PG8_LDA(At, 0, 0); PG8_STAGE(PG8_SA(1, 1), a1 + hstep, voffA);
            if constexpr (Epi::XTRA) PG8_WAIT_V(9); else PG8_WAIT_V(8); PG8_WAIT_L(0); PG8_BAR; PG8_MMA(0, 0, At, B0); PG8_MMA(0, 1, At, B1); PG8_BAR; PG8_SCHED;
            PG8_LDA(At, 0, 1); if constexpr (Epi::XTRA) PG8_XLDS(t); PG8_STAGE(PG8_SB(0, 0), b2, voffB); PG8_STAGE(PG8_SB(0, 1), b2 + hstep, voffB); PG8_STAGE(PG8_SA(0, 0), a2, voffA);
            if constexpr (Epi::XTRA) PG8_WAIT_V(9); else PG8_WAIT_V(8); PG8_WAIT_L(0); PG8_BAR; PG8_MMA(1, 0, At, B0); PG8_MMA(1, 1, At, B1); if constexpr (Epi::XTRA) PG8_XMMA(); PG8_BAR; if constexpr (Epi::XTRA) PG8_XLOAD(t + 2); PG8_SCHED;
            PG8_LDB(B0, 1, 0); PG8_LDB(B1, 1, 1); PG8_SCHED; PG8_LDA(At, 1, 0); PG8_STAGE(PG8_SA(0, 1), a2 + hstep, voffA);
            if constexpr (Epi::XTRA) PG8_WAIT_V(9); else PG8_WAIT_V(8); PG8_WAIT_L(0); PG8_BAR; PG8_MMA(0, 0, At, B0); PG8_MMA(0, 1, At, B1); PG8_BAR; PG8_SCHED;
            PG8_LDA(At, 1, 1); if constexpr (Epi::XTRA) PG8_XLDS(t + 1); PG8_STAGE(PG8_SB(1, 0), b3, voffB); PG8_STAGE(PG8_SB(1, 1), b3 + hstep, voffB); PG8_STAGE(PG8_SA(1, 0), a3, voffA);
            if constexpr (Epi::XTRA) PG8_WAIT_V(9); else PG8_WAIT_V(8); PG8_WAIT_L(0); PG8_BAR; PG8_MMA(1, 0, At, B0); PG8_MMA(1, 1, At, B1); if constexpr (Epi::XTRA) PG8_XMMA(); PG8_BAR; if constexpr (Epi::XTRA) PG8_XLOAD(t + 3); PG8_SCHED;
            } else {
            PG8_LDB(B0, 0, 0); PG8_SCHED; PG8_LDA(At, 0, 0); PG8_STAGE(PG8_SA(1, 1), a1 + hstep, voffA);
            PG8_WAIT_L(8); PG8_BAR; PG8_WAIT_L(0); PG8_MMA(0, 0, At, B0); PG8_BAR; PG8_SCHED;
            PG8_LDB(B1, 0, 1); PG8_STAGE(PG8_SB(0, 0), b2, voffB);
            PG8_BAR; PG8_WAIT_L(0); PG8_MMA(0, 1, At, B1); PG8_BAR;
            PG8_LDA(At, 0, 1); PG8_STAGE(PG8_SA(0, 0), a2, voffA);
            PG8_BAR; PG8_WAIT_L(0); PG8_MMA(1, 0, At, B0); PG8_BAR; PG8_SCHED;
            PG8_STAGE(PG8_SB(0, 1), b2 + hstep, voffB);
            PG8_WAIT_V(6); PG8_BAR; PG8_MMA(1, 1, At, B1); PG8_BAR;
            PG8_LDB(B0, 1, 0); PG8_SCHED; PG8_LDA(At, 1, 0); PG8_STAGE(PG8_SA(0, 1), a2 + hstep, voffA);
            PG8_WAIT_L(8); PG8_BAR; PG8_WAIT_L(0); PG8_MMA(0, 0, At, B0); PG8_BAR; PG8_SCHED;
            PG8_LDB(B1, 1, 1); PG8_STAGE(PG8_SB(1, 0), b3, voffB);
            PG8_BAR; PG8_WAIT_L(0); PG8_MMA(0, 1, At, B1); PG8_BAR;
            PG8_LDA(At, 1, 1); PG8_STAGE(PG8_SA(1, 0), a3, voffA);
            PG8_BAR; PG8_WAIT_L(0); PG8_MMA(1, 0, At, B0); PG8_BAR; PG8_SCHED;
            PG8_STAGE(PG8_SB(1, 1), b3 + hstep, voffB);
            PG8_WAIT_V(6); PG8_BAR; PG8_MMA(1, 1, At, B1); PG8_BAR;
            }
        }
        if constexpr (ALIGN_EPI) { if (wr == 0) PG8_BAR; }
        if constexpr (!Epi::AFTER_DRAIN) { if constexpr (Epi::CHAIN) { if (cur.seg == 0) E.mid(acc, cur, wr, wc, fr, fq); else E(acc, cur, wr, wc, fr, fq); } else E(acc, cur, wr, wc, fr, fq); S.done(cur); }
        if (!has_next) break;
        if (!(Epi::CHAIN && cur.seg == 0))
#pragma unroll
        for (int a = 0; a < 2; ++a)
#pragma unroll
            for (int b = 0; b < 2; ++b)
#pragma unroll
                for (int m = 0; m < 4; ++m)
#pragma unroll
                    for (int n = 0; n < 2; ++n) acc[a][b][m][n] = (f32x4){0.f, 0.f, 0.f, 0.f};
        cur = nxt; cA = nA; cB = nB; ++ui;
        if constexpr (ALIGN_EPI) { if (wr == 1) PG8_BAR; }
    }
    PG8_WAIT_V(0);
    if constexpr (!ALIGN_EPI) { if (wr == 0) PG8_BAR; }
    PG8_BAR;
    if constexpr (Epi::AFTER_DRAIN) { if constexpr (Epi::XTRA) E.fused(acc, xacc, cur, wr, wc, fr, fq, lds, wid, lane); else E.fused(acc, cur, wr, wc, fr, fq, lds, wid, lane); S.done(cur); }
#undef PG8_XLOAD
#undef PG8_XLDS
#undef PG8_XMMA
#undef PG8_SA
#undef PG8_SB
#undef PG8_STAGE
#undef PG8_LDA
#undef PG8_LDB
#undef PG8_MMA
#undef PG8_WAIT_V
#undef PG8_WAIT_L
#undef PG8_BAR
#undef PG8_SCHED
}
}
#define GAS __attribute__((address_space(1)))
#define LAS __attribute__((address_space(3)))
typedef unsigned short bf16;
typedef unsigned v4u __attribute__((ext_vector_type(4)));
typedef float f32x4 __attribute__((ext_vector_type(4)));
typedef short bf16x8 __attribute__((ext_vector_type(8)));
typedef GAS unsigned gu32;
typedef GAS unsigned long long gu64;
#define RLX_AGENT __ATOMIC_RELAXED, __HIP_MEMORY_SCOPE_AGENT
#define LDS_WAIT() asm volatile("s_waitcnt lgkmcnt(0)" ::: "memory")
#define VM_WAIT() asm volatile("s_waitcnt vmcnt(0)" ::: "memory")
__device__ __forceinline__ unsigned long long rt() { return __builtin_amdgcn_s_memrealtime(); }
__device__ __forceinline__ unsigned f2bf(float f) { unsigned u = __builtin_bit_cast(unsigned, f); return (u + 0x7fffu + ((u >> 16) & 1u)) >> 16; }
__device__ __forceinline__ unsigned pk2(float lo, float hi) { return f2bf(lo) | (f2bf(hi) << 16); }

#define XB_TMO      128
#define XB_XCNT(j)  (256  + 64 * (j))
#define XB_XSUB(j)  (1280 + 64 * (j))
#define XB_XGEN(j)  (2304 + 64 * (j))
#define XB_TOP      3328
#define XB_TOPGEN   3392
#define XCD_BAR_WORDS 3456
#define XB_SPIN_CAP (1u << 18)

__device__ __forceinline__ unsigned xb_ld(unsigned* p)              { return __hip_atomic_load(p, __ATOMIC_RELAXED, __HIP_MEMORY_SCOPE_AGENT); }
__device__ __forceinline__ unsigned xb_add(unsigned* p, unsigned v) { return __hip_atomic_fetch_add(p, v, __ATOMIC_RELAXED, __HIP_MEMORY_SCOPE_AGENT); }
__device__ __forceinline__ unsigned xb_xcc_id() { return (unsigned)__builtin_amdgcn_s_getreg((3 << 11) | 20) & 0xFu; }
#define XB_SPIN(cond, bar) do { unsigned _sp = 0; while (cond) { __builtin_amdgcn_s_sleep(1); \
    if ((++_sp & 255u) == 0u) { if (xb_ld(&(bar)[XB_TMO])) break; if (_sp > XB_SPIN_CAP) { atomicAdd(&(bar)[XB_TMO], 1u); break; } } } } while (0)

struct XcdBarrier {
    unsigned* bar; unsigned x;
    volatile LAS unsigned* st;
};

__device__ __forceinline__ XcdBarrier xcd_barrier_post(unsigned* bar, volatile LAS unsigned* st) {
    XcdBarrier b; b.bar = bar; b.x = xb_xcc_id(); b.st = st;
    if (threadIdx.x == 0) (void)xb_add(&bar[XB_XCNT(b.x)], 1u);
    return b;
}
__device__ __forceinline__ void xcd_barrier_complete(unsigned* bar, unsigned x, unsigned& nloc, unsigned& nx) {
    const unsigned G = gridDim.x * gridDim.y * gridDim.z;
    unsigned sum, cnt, mine, sp = 0u;
    for (;;) {
        sum = 0u; cnt = 0u; mine = 0u;
#pragma unroll
        for (unsigned j = 0; j < 16; ++j) { const unsigned c = xb_ld(&bar[XB_XCNT(j)]); sum += c; cnt += (c > 0u) ? 1u : 0u; mine = (j == x) ? c : mine; }
        if (sum == G) break;
        __builtin_amdgcn_s_sleep(1);
        if ((++sp & 255u) == 0u) { if (xb_ld(&bar[XB_TMO])) break; if (sp > XB_SPIN_CAP) { atomicAdd(&bar[XB_TMO], 1u); break; } }
    }
    nloc = mine > 0u ? mine : 1u; nx = cnt > 0u ? cnt : 1u;
}

__device__ __forceinline__ void xcd_barrier(const XcdBarrier& b) {
    asm volatile("s_waitcnt vmcnt(0)" ::: "memory");
    __syncthreads();
    if (threadIdx.x == 0) {
        unsigned* bar = b.bar;
        __builtin_amdgcn_s_waitcnt(0);
        unsigned nloc = b.st[0], nx = b.st[1];
        if (nloc == 0u) { xcd_barrier_complete(bar, b.x, nloc, nx); b.st[0] = nloc; b.st[1] = nx; }
        const unsigned old = xb_add(&bar[XB_XSUB(b.x)], 1u);
        const unsigned gen = old / nloc;
        if (old + 1u == (gen + 1u) * nloc) {
            __builtin_amdgcn_fence(__ATOMIC_RELEASE, "agent");
            asm volatile("s_waitcnt vmcnt(0)" ::: "memory");
            const unsigned og = xb_add(&bar[XB_TOP], 1u);
            const unsigned tg = og / nx;
            if (og + 1u == (tg + 1u) * nx) xb_add(&bar[XB_TOPGEN], 1u);
            else XB_SPIN(xb_ld(&bar[XB_TOPGEN]) == tg, bar);
            __builtin_amdgcn_fence(__ATOMIC_ACQUIRE, "agent");
            xb_add(&bar[XB_XGEN(b.x)], 1u);
            asm volatile("s_waitcnt vmcnt(0)" ::: "memory");
        } else {
            XB_SPIN(xb_ld(&bar[XB_XGEN(b.x)]) == gen, bar);
            __builtin_amdgcn_fence(__ATOMIC_ACQUIRE, "agent");
            asm volatile("s_waitcnt vmcnt(0)" ::: "memory");
        }
    }
    __syncthreads();
}
typedef unsigned u32x4q __attribute__((ext_vector_type(4))); typedef unsigned u32x2q __attribute__((ext_vector_type(2)));
constexpr int NWAVES = 8;
#ifndef MK_SINGLE
#define MK_SINGLE 1
#endif
constexpr int DM = 1024, SEQ = 8192, NB = 2, DB = 8, DSEQ = 64, PAST = 2048, FF = 2816;
constexpr int MP = NB * SEQ, MS = DB * DSEQ, M = MP + MS;
constexpr int NSTREAM = NB + DB;
constexpr int NG = 32, GC = 16, NP = 64, S5W = 512, QW = 512, INW = 3328, NMOD = 9216;
constexpr int KXROWS = MP + DB * 192;
constexpr float RMS_EPS = 1e-6f;
constexpr float QSCALE = 0.125f * 1.4426950408889634f;
constexpr size_t O_Y = 0, O_KWP = 17301504, O_VWP = 17334272, O_S5RP = 17367040, O_S5IP = 17371136, O_KWS = 17375232, O_VWS = 17506304, O_S5RS = 17637376, O_S5IS = 17653760, O_END = 17670144;
constexpr size_t MiB = 1u << 20;
constexpr size_t WS_CTL = 0, CTL_ZERO_BYTES = 64 * 1024;
constexpr size_t WS_KXS = 64 * 1024, WS_VTS = 448 * 1024;
constexpr size_t WS_MOD = 2 * MiB + 576 * 1024;
constexpr size_t WS_NPART = 3 * MiB;
constexpr size_t WS_ROPE = 2 * MiB + 64 * 1024;
constexpr size_t WS_W1I = 4 * MiB, WS_W1O = 15 * MiB, WS_W2I = 20 * MiB + 512 * 1024, WS_W2O = 31 * MiB + 512 * 1024, WS_WIN = 37 * MiB, WS_WGLU = 43 * MiB + 512 * 1024, WS_WS5P = 44 * MiB, WS_WAP = 45 * MiB, WS_WOUT = 46 * MiB;
constexpr size_t WS_XN = 50 * MiB;
constexpr size_t WS_A = 83 * MiB;
constexpr size_t WS_S5U = WS_A, WS_Q = WS_A + 17 * MiB, WS_KX = WS_A + 34 * MiB, WS_VTP = WS_A + 39 * MiB, WS_YS5 = WS_A + 44 * MiB, WS_Y2 = WS_A + 61 * MiB;
constexpr size_t WS_GS5 = 174 * MiB, WS_GATT = 207 * MiB;
constexpr size_t WS_KT = 48 * MiB;
constexpr size_t WS_G = WS_A + 80 * MiB;
constexpr size_t WS_HP = WS_A + 85 * MiB;
constexpr size_t WS_MIN = 240 * MiB, WS_MOUT = 248 * MiB, WS_END = 256 * MiB;
constexpr int NCH = 264, NCHP = 272;

static_assert(WS_W1I + (size_t)2 * FF * DM * 2 <= WS_W1O && WS_W1O + (size_t)DM * FF * 2 <= WS_W2I && WS_W2I + (size_t)2 * FF * DM * 2 <= WS_W2O && WS_W2O + (size_t)DM * FF * 2 <= WS_WIN, "ws map 1");
static_assert(WS_WIN + (size_t)INW * DM * 2 <= WS_WGLU && WS_WOUT + (size_t)DM * DM * 2 <= WS_KT && WS_KT + (size_t)NG * 65 * 512 <= WS_XN && WS_XN + (size_t)M * DM * 2 <= WS_A && WS_A + (size_t)M * FF * 2 <= WS_GS5, "ws map 2");
static_assert(WS_S5U + (size_t)M * 512 * 2 <= WS_Q && WS_Q + (size_t)M * 512 * 2 <= WS_KX && WS_KX + (size_t)MP * 128 * 2 <= WS_VTP && WS_VTP + (size_t)4 * MiB <= WS_YS5, "ws map 3");
static_assert(WS_YS5 + (size_t)M * 512 * 2 <= WS_Y2 && WS_Y2 + (size_t)M * 512 * 2 <= WS_GS5 && WS_GS5 + (size_t)M * DM * 2 <= WS_GATT && WS_GATT + (size_t)M * DM * 2 <= WS_MIN, "ws map 4");
constexpr int CW_TMO = 0, CW_CODE = 1, CW_WORK = 64, CW_BAR = 4096, CW_NORM = 8192;
constexpr int RING_OFF = 0, RING_BYTES = 131072, LDSCTL_OFF = RING_BYTES, MISC_OFF = LDSCTL_OFF + 320, LDS_BYTES = 147456;

struct Args { const float* in[35]; float* out; unsigned char* ws; int ph_lo, ph_hi, li, pad; };
typedef const __attribute__((address_space(4))) Args* KArgs;
struct Frame {
    LAS unsigned char* lds; volatile LAS unsigned* MISC; gu32* ctl;
    int tid, lane, wave, vcu, G;
    KArgs ap; float* out; unsigned char* ws;
};
#define INP(k) (F.ap->in[k])
#define LAUNDER_ARGS() asm volatile("" : "+s"(F.ap))
__device__ __forceinline__ float wave_sum(float v) {
#pragma unroll
    for (int o = 1; o < 64; o <<= 1) v += __shfl_xor(v, o);
    return v;
}
__device__ __forceinline__ float bf2f(bf16 x) { return __uint_as_float((unsigned)x << 16); }
__device__ __forceinline__ int row_stream(int r) { return r < MP ? (r >> 13) : 2 + ((r - MP) >> 6); }

__device__ __forceinline__ void sincos_d(double x, double& s, double& c) {
    const double q = rint(x * 0.63661977236758134308);
    double r = fma(-q, 1.57079632673412561417e+00, x); r = fma(-q, 6.07710050650619224932e-11, r);
    const double r2 = r * r;
    double sp = 1.0 / 6227020800.0; sp = fma(sp, r2, -1.0 / 39916800.0); sp = fma(sp, r2, 1.0 / 362880.0); sp = fma(sp, r2, -1.0 / 5040.0); sp = fma(sp, r2, 1.0 / 120.0); sp = fma(sp, r2, -1.0 / 6.0);
    const double sr = fma(r * r2, sp, r);
    double cp = -1.0 / 87178291200.0; cp = fma(cp, r2, 1.0 / 479001600.0); cp = fma(cp, r2, -1.0 / 3628800.0); cp = fma(cp, r2, 1.0 / 40320.0); cp = fma(cp, r2, -1.0 / 720.0); cp = fma(cp, r2, 1.0 / 24.0); cp = fma(cp, r2, -0.5);
    const double cr = fma(r2, cp, 1.0);
    const int n = (int)((long long)q & 3);
    s = (n == 0) ? sr : (n == 1) ? cr : (n == 2) ? -sr : -cr;
    c = (n == 0) ? cr : (n == 1) ? -sr : (n == 2) ? -cr : sr;
}

__device__ __forceinline__ void transpose_item(const float* W, int K, int N, bf16* WT, int n0, int src0, int kb, LAS float* scr, int lane) {
    const int k0 = 64 * kb;
    float wv[32];
#pragma unroll
    for (int i = 0; i < 32; ++i) { const int kk = 2 * i + (lane >> 5); wv[i] = W[(size_t)(k0 + kk) * N + src0 + (lane & 31)]; }
#pragma unroll
    for (int i = 0; i < 32; ++i) { const int kk = 2 * i + (lane >> 5); scr[kk * 33 + (lane & 31)] = wv[i]; }
    LDS_WAIT(); asm volatile("" ::: "memory");
    const int c = lane & 7;
#pragma unroll
    for (int j = 0; j < 4; ++j) { const int n = (lane >> 3) + 8 * j; const LAS float* s = scr + (8 * c) * 33 + n;
        v4u o; o.x = pk2(s[0 * 33], s[1 * 33]); o.y = pk2(s[2 * 33], s[3 * 33]); o.z = pk2(s[4 * 33], s[5 * 33]); o.w = pk2(s[6 * 33], s[7 * 33]);
        *(GAS v4u*)(WT + (size_t)(n0 + n) * K + k0 + 8 * c) = o; }
    LDS_WAIT(); asm volatile("" ::: "memory");
}
__device__ __forceinline__ int src_ffn_in(int n0) { const int t = n0 >> 8, h = (n0 >> 7) & 1, i0 = n0 & 127; return h * FF + 128 * t + i0; }
__device__ __forceinline__ int src_win(int n0) {
    const int t = n0 >> 8, ct = n0 & 255;
    if (t < 2) return n0;
    const int bj = ct >> 7, wc = (ct >> 5) & 3;
    if (t < 4) return 512 + ((t - 2) * 4 + wc) * 64 + 32 * bj;
    if (t == 4) return (wc < 2 ? 1024 + wc * 64 : 1152 + (wc - 2) * 64) + 32 * bj;
    return 1280 + (n0 - 5 * 256);
}

__device__ __forceinline__ void convert_item(Frame& F, int group, int r, LAS float* scr) {
    constexpr int I_FI = (DM / 64) * (2 * FF / 32), I_FO = (FF / 64) * (DM / 32), I_IN = (DM / 64) * (INW / 32), I_GLU = (512 / 64) * (512 / 32), I_P = (512 / 64) * (DM / 32), I_O = (DM / 64) * (DM / 32);
    if (group == 0) { const int nblk = 2 * FF / 32, kb = r / nblk, n0 = (r % nblk) * 32; transpose_item(INP(11), DM, 2 * FF, (bf16*)(F.ws + WS_W1I), n0, src_ffn_in(n0), kb, scr, F.lane); return; }
    if (group == 1) {
        if (r < I_FO) { const int nblk = DM / 32, kb = r / nblk, n0 = (r % nblk) * 32; transpose_item(INP(12), FF, DM, (bf16*)(F.ws + WS_W1O), n0, n0, kb, scr, F.lane); return; } r -= I_FO;
        { const int nblk = INW / 32, kb = r / nblk, n0 = (r % nblk) * 32; transpose_item(INP(14), DM, INW, (bf16*)(F.ws + WS_WIN), n0, src_win(n0), kb, scr, F.lane); } return; }
    if (group == 3) { const int nblk = 2 * FF / 32, kb = r / nblk, n0 = (r % nblk) * 32; transpose_item(INP(32), DM, 2 * FF, (bf16*)(F.ws + WS_W2I), n0, src_ffn_in(n0), kb, scr, F.lane); return; }
    if (r < I_FO) { const int nblk = DM / 32, kb = r / nblk, n0 = (r % nblk) * 32; transpose_item(INP(33), FF, DM, (bf16*)(F.ws + WS_W2O), n0, n0, kb, scr, F.lane); return; } r -= I_FO;
    if (r < I_GLU) { const int nblk = 512 / 32, kb = r / nblk, n0 = (r % nblk) * 32; transpose_item(INP(23), 512, 512, (bf16*)(F.ws + WS_WGLU), n0, n0, kb, scr, F.lane); return; } r -= I_GLU;
    if (r < 2 * I_P) { const int which = r / I_P; r -= which * I_P; const int nblk = DM / 32, kb = r / nblk, n0 = (r % nblk) * 32;
        transpose_item(which ? INP(29) : INP(25), 512, DM, (bf16*)(F.ws + (which ? WS_WAP : WS_WS5P)), n0, n0, kb, scr, F.lane); return; } r -= 2 * I_P;
    if (group == 2) { const int nblk = DM / 32, kb = r / nblk, n0 = (r % nblk) * 32; transpose_item(INP(30), DM, DM, (bf16*)(F.ws + WS_WOUT), n0, n0, kb, scr, F.lane); return; }
    if (r < I_FI) { const int nblk = 2 * FF / 32, kb = r / nblk, n0 = (r % nblk) * 32; transpose_item(INP(32), DM, 2 * FF, (bf16*)(F.ws + WS_W2I), n0, src_ffn_in(n0), kb, scr, F.lane); return; } r -= I_FI;
    { const int nblk = DM / 32, kb = r / nblk, n0 = (r % nblk) * 32; transpose_item(INP(33), FF, DM, (bf16*)(F.ws + WS_W2O), n0, n0, kb, scr, F.lane); }
}
__device__ __host__ constexpr int convert_count(int group) {
    constexpr int I_FI = (DM / 64) * (2 * FF / 32), I_FO = (FF / 64) * (DM / 32), I_IN = (DM / 64) * (INW / 32), I_GLU = (512 / 64) * (512 / 32), I_P = (512 / 64) * (DM / 32), I_O = (DM / 64) * (DM / 32);
    return group == 0 ? I_FI : group == 1 ? I_FO + I_IN : group == 2 ? I_FO + I_GLU + 2 * I_P + I_O : I_FI;
}
__device__ __forceinline__ void rope_table(Frame& F, int wgi, int nwg);
__device__ __forceinline__ void s5_tables(Frame& F, int wgi, int nwg);
__device__ __forceinline__ void convert_idle(Frame& F, int group, int c, int c0) {
    if (c < c0) return;
    LAS float* scr = (LAS float*)(F.lds + RING_OFF + F.wave * 16384);
    const int nw = (F.G - c0) * NWAVES;
    for (int it = (c - c0) * NWAVES + F.wave; it < convert_count(group); it += nw) convert_item(F, group, it, scr);
    if (group == 1) rope_table(F, c - c0, F.G - c0);
    if (group == 2) { __syncthreads(); s5_tables(F, c - c0, F.G - c0); }
}
template <bool FAST> __device__ __forceinline__ void s5_param(Frame& F, int g, int p, double& lrd, double& lid, double& fre, double& fim) {
    const double dt = FAST ? (double)__expf(INP(15)[g]) : exp((double)INP(15)[g]); const double lr = fmin((double)INP(16)[g * NP + p], -1e-4), li = (double)INP(17)[g * NP + p];
    lrd = lr * dt; lid = li * dt;
    const double mag = FAST ? (double)__expf((float)lrd) : exp(lrd); double s, c; sincos_d(lid, s, c);
    const double nr = mag * c - 1.0, ni = mag * s, den = lr * lr + li * li;
    fre = (nr * lr + ni * li) / den; fim = (ni * lr - nr * li) / den;
}
template <bool FAST> __device__ __forceinline__ void s5_pow(double lrd, double lid, int tau, double& re, double& im) { const double mag = FAST ? (double)__expf((float)(lrd * (double)tau)) : exp(lrd * (double)tau); double s, c; sincos_d(lid * (double)tau, s, c); re = mag * c; im = mag * s; }

__device__ __forceinline__ void rope_table(Frame& F, int wgi, int nwg) {
    const int gt = wgi * NWAVES * 64 + F.tid, NGT = nwg * NWAVES * 64;
    {
        float* rope = (float*)(F.ws + WS_ROPE);
        for (int i = gt; i < SEQ * 8; i += NGT) { const int pos = i >> 3, k = i & 7;
            const double f = k == 0 ? 1.0 : k == 1 ? 0.19392274474868576 : k == 2 ? 0.03760603093086393 : k == 3 ? 0.007292664737217109 : k == 4 ? 0.001414213562373095 : k == 5 ? 0.0002742481756762073 : k == 6 ? 5.318295896944988e-05 : 1.031338537721246e-05;
            double s, c; sincos_d((double)pos * f, s, c); rope[pos * 16 + k] = (float)c; rope[pos * 16 + 8 + k] = (float)s; }
    }
}
__device__ __forceinline__ void s5_tables(Frame& F, int wgi, int nwg) {
    const int gt = wgi * NWAVES * 64 + F.tid, NGT = nwg * NWAVES * 64;
    {
        const float* bre = INP(18); const float* bim = INP(19); const float* cre = INP(20); const float* cim = INP(21); const float* dsk = INP(22);
        bf16* Kt = (bf16*)(F.ws + WS_KT); bf16* Min = (bf16*)(F.ws + WS_MIN); bf16* Mout = (bf16*)(F.ws + WS_MOUT);
    {
        LAS float* Lc = (LAS float*)(F.lds + RING_OFF);
        LAS float* Lb = Lc + 2048;
        LAS float* Lz = Lb + 2048 + F.wave * 128;
        __syncthreads();
        for (int task = wgi; task < NG * 8; task += nwg) { const int g = task >> 3, tau = (task & 7) * 8 + F.wave, c = F.lane & 15, cq = F.lane >> 4;
            for (int i = F.tid; i < 1024; i += NWAVES * 64) { const int pp = i >> 4, cc = i & 15;
                Lc[(pp * 16 + cc) * 2] = cre[(size_t)(g * GC + cc) * NP + pp]; Lc[(pp * 16 + cc) * 2 + 1] = cim[(size_t)(g * GC + cc) * NP + pp];
                Lb[pp * 32 + cc] = bre[(size_t)(g * NP + pp) * GC + cc]; Lb[pp * 32 + 16 + cc] = bim[(size_t)(g * NP + pp) * GC + cc]; }
            { double lrd, lid, fre, fim, pr, pi; s5_param<true>(F, g, F.lane, lrd, lid, fre, fim); s5_pow<true>(lrd, lid, tau, pr, pi);
              Lz[F.lane * 2] = (float)(pr * fre - pi * fim); Lz[F.lane * 2 + 1] = (float)(pr * fim + pi * fre); }
            LDS_WAIT(); __syncthreads();
            f32x4 acc = {0.f, 0.f, 0.f, 0.f};
#pragma unroll 8
            for (int p = 0; p < NP; ++p) { const float ar = Lz[2 * p], ai = Lz[2 * p + 1]; const float c_r = Lc[(p * 16 + c) * 2], c_i = Lc[(p * 16 + c) * 2 + 1];
                const float er = c_r * ar - c_i * ai, ei = c_r * ai + c_i * ar;
                const f32x4 vbr = *(const LAS f32x4*)(Lb + p * 32 + 4 * cq), vbi = *(const LAS f32x4*)(Lb + p * 32 + 16 + 4 * cq);
                acc += vbr * er - vbi * ei; }
            if (tau == 0 && (c >> 2) == cq) { const float dv = dsk[g * GC + c];
#pragma unroll
                for (int k = 0; k < 4; ++k) acc[k] += ((c & 3) == k) ? dv : 0.f; }
            u32x2q w; w.x = pk2(acc[0], acc[1]); w.y = pk2(acc[2], acc[3]);
            *(GAS u32x2q*)(Kt + ((size_t)(g * 65 + tau + 1) * 16 + c) * 16 + 4 * cq) = w;
            if (tau == 0) { u32x2q zz; zz.x = 0u; zz.y = 0u; *(GAS u32x2q*)(Kt + ((size_t)(g * 65) * 16 + c) * 16 + 4 * cq) = zz; }
            __syncthreads();
        } }
        for (int i = gt; i < NG * NP * 64; i += NGT) { const int g = i >> 12, p = (i >> 6) & 63, s = i & 63;
            double lrd, lid, fre, fim, pr, pi; s5_param<true>(F, g, p, lrd, lid, fre, fim); s5_pow<true>(lrd, lid, 63 - s, pr, pi);
            const float ar = (float)(pr * fre - pi * fim), ai = (float)(pr * fim + pi * fre);
            const float* br = bre + (size_t)(g * NP + p) * GC; const float* bi = bim + (size_t)(g * NP + p) * GC;
            f32x4 vr[4], vi[4];
#pragma unroll
            for (int k = 0; k < 4; ++k) { const f32x4 x = *(const f32x4*)(br + 4 * k), y = *(const f32x4*)(bi + 4 * k); vr[k] = x * ar - y * ai; vi[k] = y * ar + x * ai; }
            v4u o;
            GAS v4u* dre = (GAS v4u*)(Min + ((size_t)(g * 128 + p) * 1024 + s * 16)); GAS v4u* dim = (GAS v4u*)(Min + ((size_t)(g * 128 + 64 + p) * 1024 + s * 16));
            o.x = pk2(vr[0][0], vr[0][1]); o.y = pk2(vr[0][2], vr[0][3]); o.z = pk2(vr[1][0], vr[1][1]); o.w = pk2(vr[1][2], vr[1][3]); dre[0] = o;
            o.x = pk2(vr[2][0], vr[2][1]); o.y = pk2(vr[2][2], vr[2][3]); o.z = pk2(vr[3][0], vr[3][1]); o.w = pk2(vr[3][2], vr[3][3]); dre[1] = o;
            o.x = pk2(vi[0][0], vi[0][1]); o.y = pk2(vi[0][2], vi[0][3]); o.z = pk2(vi[1][0], vi[1][1]); o.w = pk2(vi[1][2], vi[1][3]); dim[0] = o;
            o.x = pk2(vi[2][0], vi[2][1]); o.y = pk2(vi[2][2], vi[2][3]); o.z = pk2(vi[3][0], vi[3][1]); o.w = pk2(vi[3][2], vi[3][3]); dim[1] = o; }
    }
    {
        const float* cre = INP(20); const float* cim = INP(21); bf16* Mout = (bf16*)(F.ws + WS_MOUT);
        LAS float* pw = (LAS float*)(F.lds + RING_OFF);
        __syncthreads();
        for (int task = wgi; task < NG * 8; task += nwg) { const int g = task >> 3, t0 = (task & 7) * 8;
            { const int tl = F.tid >> 6, p = F.tid & 63; double lrd, lid, fre, fim, pr, pi; s5_param<true>(F, g, p, lrd, lid, fre, fim); s5_pow<true>(lrd, lid, t0 + tl + 1, pr, pi);
              pw[(tl * 64 + p) * 2] = (float)pr; pw[(tl * 64 + p) * 2 + 1] = (float)pi; }
            LDS_WAIT(); __syncthreads();
#pragma unroll 1
            for (int k = 0; k < 2; ++k) { const int idx = F.tid + 512 * k, tl = idx >> 7, c = (idx >> 3) & 15, p = (idx & 7) * 8;
                const float* cr = cre + (size_t)(g * GC + c) * NP + p; const float* ci = cim + (size_t)(g * GC + c) * NP + p;
                float re[8], im[8];
#pragma unroll
                for (int j = 0; j < 8; ++j) { const float a_r = pw[(tl * 64 + p + j) * 2], a_i = pw[(tl * 64 + p + j) * 2 + 1], c_r = cr[j], c_i = ci[j]; re[j] = c_r * a_r - c_i * a_i; im[j] = -(c_r * a_i + c_i * a_r); }
                bf16* d = Mout + (size_t)((g * 64 + t0 + tl) * GC + c) * 128 + p;
                v4u o; o.x = pk2(re[0], re[1]); o.y = pk2(re[2], re[3]); o.z = pk2(re[4], re[5]); o.w = pk2(re[6], re[7]); *(GAS v4u*)d = o;
                o.x = pk2(im[0], im[1]); o.y = pk2(im[2], im[3]); o.z = pk2(im[4], im[5]); o.w = pk2(im[6], im[7]); *(GAS v4u*)(d + 64) = o; }
            __syncthreads();
        }
    }
}
__device__ __forceinline__ void p0_prologue(Frame& F) {
    {
        LAS float* sc = (LAS float*)(F.lds + RING_OFF);
        LAS float* red = (LAS float*)(F.lds + RING_OFF + 40960);
        const float* w_ada = INP(8); const float* b_ada = INP(9); float* mod = (float*)(F.ws + WS_MOD);
        bool did = false;
        for (int it = F.vcu; it < NMOD / 64; it += F.G) {
            if (!did) {
                for (int i = F.tid; i < NSTREAM * DM; i += NWAVES * 64) { const int s = i >> 10, k = i & 1023; const float c = s < NB ? INP(6)[s * DM + k] : INP(7)[(s - NB) * DM + k]; sc[i] = c / (1.0f + __expf(-c)); }
                __syncthreads(); did = true;
            }
            const int j = it * 64 + F.lane; float acc[NSTREAM];
#pragma unroll
            for (int s = 0; s < NSTREAM; ++s) acc[s] = 0.f;
            const int k0 = F.wave * 128;
#pragma unroll 1
            for (int kb = 0; kb < 128; kb += 32) { float wv[32];
#pragma unroll
                for (int k = 0; k < 32; ++k) wv[k] = w_ada[(size_t)(k0 + kb + k) * NMOD + j];
#pragma unroll
                for (int s = 0; s < NSTREAM; ++s)
#pragma unroll
                    for (int k4 = 0; k4 < 8; ++k4) { const f32x4 c4 = *(const LAS f32x4*)(sc + s * DM + k0 + kb + 4 * k4);
                        acc[s] += c4[0] * wv[4 * k4] + c4[1] * wv[4 * k4 + 1] + c4[2] * wv[4 * k4 + 2] + c4[3] * wv[4 * k4 + 3]; } }
#pragma unroll
            for (int s = 0; s < NSTREAM; ++s) red[(F.wave * NSTREAM + s) * 64 + F.lane] = acc[s];
            __syncthreads();
            for (int i = F.tid; i < NSTREAM * 64; i += NWAVES * 64) { const int s = i >> 6, l = i & 63; float v = b_ada[it * 64 + l];
#pragma unroll
                for (int w = 0; w < NWAVES; ++w) v += red[(w * NSTREAM + s) * 64 + l];
                mod[(size_t)s * NMOD + it * 64 + l] = v; }
            __syncthreads();
        }
        __syncthreads();
    }
    const int gw = F.vcu * NWAVES + F.wave, NGW = F.G * NWAVES;
    const int gt = F.vcu * NWAVES * 64 + F.tid, NGT = F.G * NWAVES * 64;
    {
        LAS float* scr = (LAS float*)(F.lds + RING_OFF + F.wave * 16384);
        for (int itb = 0, iti = 16;; ++iti) {
            if (iti == 16) { int v = 0; if (F.lane == 0) v = (int)__hip_atomic_fetch_add((unsigned*)(F.ctl + CW_WORK), 16u, __ATOMIC_RELAXED, __HIP_MEMORY_SCOPE_AGENT); itb = __builtin_amdgcn_readfirstlane(v); iti = 0; }
            const int it = itb + iti; if (it >= convert_count(0)) break;
            convert_item(F, 0, it, scr);
        }
    }
    {
        bf16* KXS = (bf16*)(F.ws + WS_KXS); bf16* VTS = (bf16*)(F.ws + WS_VTS);
        const float* ck = INP(2); const float* cv = INP(3);
        for (int i = gt; i < DB * 128 * 128; i += NGT) { const int sb = i >> 14, w = (i >> 7) & 127, c = i & 127, kvh = c >> 6, d = c & 63;
            const float kvv = ck[i], vv = cv[i];
            KXS[(size_t)(sb * 192 + w) * 128 + c] = (bf16)f2bf(kvv);
            VTS[(size_t)((sb * 2 + kvh) * 64 + d) * 192 + w] = (bf16)f2bf(vv);
            if (w >= 64) { F.out[O_KWS + (size_t)(sb * 128 + (w - 64)) * 128 + c] = kvv; F.out[O_VWS + (size_t)(sb * 128 + (w - 64)) * 128 + c] = vv; } }
    }
}
__device__ __forceinline__ void modulate_pass(Frame& F, int sub, bool from_x, const float* gnorm);
__device__ __forceinline__ void p0b_prologue(Frame& F) { modulate_pass(F, 0, true, INP(10)); }

__device__ __forceinline__ void hp_sample_init(Frame& F) {
    const int gt = F.vcu * NWAVES * 64 + F.tid, NGT = F.G * NWAVES * 64;
    {
        bf16* HP = (bf16*)(F.ws + WS_HP);
        for (int i = gt; i < DB * NG * NP; i += NGT) { const int sb = i >> 11, g = (i >> 6) & 31, p = i & 63;
            HP[(size_t)(g * NCHP + 256 + sb) * 128 + p] = (bf16)f2bf(INP(4)[i]); HP[(size_t)(g * NCHP + 256 + sb) * 128 + 64 + p] = (bf16)f2bf(INP(5)[i]); }
    }
}
__device__ __forceinline__ void modulate_pass(Frame& F, int sub, bool from_x, const float* gnorm) {
    const int gw = F.vcu * NWAVES + F.wave, NGW = F.G * NWAVES;
    const float* mod = (const float*)(F.ws + WS_MOD); bf16* XN = (bf16*)(F.ws + WS_XN); const bf16* Hb = (const bf16*)F.out;
    for (int r0 = 2 * gw; r0 < M; r0 += 2 * NGW) {
        f32x4 v[2][4]; float ss[2];
#pragma unroll
        for (int q = 0; q < 2; ++q) { const int r = r0 + q;
            if (from_x) { const float* src = r < MP ? INP(0) + (size_t)r * DM : INP(1) + (size_t)(r - MP) * DM;
                const GAS f32x4* xr = (const GAS f32x4*)src + 2 * F.lane;
                v[q][0] = xr[0]; v[q][1] = xr[1]; v[q][2] = xr[128]; v[q][3] = xr[129]; }
            else { const GAS v4u* xr = (const GAS v4u*)(Hb + (size_t)r * DM) + F.lane;
#pragma unroll
                for (int j = 0; j < 2; ++j) { const v4u x = xr[64 * j];
                    v[q][2 * j] = (f32x4){__uint_as_float(x.x << 16), __uint_as_float(x.x & 0xffff0000u), __uint_as_float(x.y << 16), __uint_as_float(x.y & 0xffff0000u)};
                    v[q][2 * j + 1] = (f32x4){__uint_as_float(x.z << 16), __uint_as_float(x.z & 0xffff0000u), __uint_as_float(x.w << 16), __uint_as_float(x.w & 0xffff0000u)}; } } }
#pragma unroll
        for (int q = 0; q < 2; ++q) { float s_ = 0.f;
#pragma unroll
            for (int j = 0; j < 4; ++j) s_ += (v[q][j].x * v[q][j].x + v[q][j].y * v[q][j].y) + (v[q][j].z * v[q][j].z + v[q][j].w * v[q][j].w);
            ss[q] = s_; }
#pragma unroll
        for (int q = 0; q < 2; ++q) { const int r = r0 + q; const int s = row_stream(r);
            const float* sh = mod + (size_t)s * NMOD + (sub * 3 + 0) * DM; const float* scl = mod + (size_t)s * NMOD + (sub * 3 + 1) * DM;
            const float rstd = 1.0f / sqrtf(wave_sum(ss[q]) * (1.0f / DM) + RMS_EPS);
            GAS v4u* o16 = (GAS v4u*)(XN + (size_t)r * DM) + F.lane;
#pragma unroll
            for (int j = 0; j < 2; ++j) { const int c = 512 * j + 8 * F.lane; f32x4 y[2];
#pragma unroll
                for (int h = 0; h < 2; ++h) { const f32x4 g = *(const f32x4*)(gnorm + c + 4 * h), a = *(const f32x4*)(scl + c + 4 * h), b = *(const f32x4*)(sh + c + 4 * h); y[h] = v[q][2 * j + h] * rstd * g * (a + 1.0f) + b; }
                v4u o; o.x = pk2(y[0].x, y[0].y); o.y = pk2(y[0].z, y[0].w); o.z = pk2(y[1].x, y[1].y); o.w = pk2(y[1].z, y[1].w); o16[64 * j] = o; } }
    }
}
__device__ __forceinline__ void final_norm_pass(Frame& F, const bf16* src16, float* out) {
    const int gw = F.vcu * NWAVES + F.wave, NGW = F.G * NWAVES; const float* gnorm = INP(34);
    for (int r0 = 2 * gw; r0 < M; r0 += 2 * NGW) {
        v4u w[2][2]; float ss[2];
#pragma unroll
        for (int q = 0; q < 2; ++q) { const GAS v4u* xr = (const GAS v4u*)(src16 + (size_t)(r0 + q) * DM) + F.lane;
            w[q][0] = xr[0]; w[q][1] = xr[64]; }
#pragma unroll
        for (int q = 0; q < 2; ++q) { float s_ = 0.f;
#pragma unroll
            for (int j = 0; j < 2; ++j) { const v4u x = w[q][j]; const float e0 = __uint_as_float(x.x << 16), e1 = __uint_as_float(x.x & 0xffff0000u), e2 = __uint_as_float(x.y << 16), e3 = __uint_as_float(x.y & 0xffff0000u),
                    e4 = __uint_as_float(x.z << 16), e5 = __uint_as_float(x.z & 0xffff0000u), e6 = __uint_as_float(x.w << 16), e7 = __uint_as_float(x.w & 0xffff0000u);
                s_ += ((e0 * e0 + e1 * e1) + (e2 * e2 + e3 * e3)) + ((e4 * e4 + e5 * e5) + (e6 * e6 + e7 * e7)); }
            ss[q] = s_; }
#pragma unroll
        for (int q = 0; q < 2; ++q) { const float rstd = 1.0f / sqrtf(wave_sum(ss[q]) * (1.0f / DM) + RMS_EPS);
            GAS f32x4* yo = (GAS f32x4*)(out + (size_t)(r0 + q) * DM);
#pragma unroll
            for (int j = 0; j < 2; ++j) { const v4u x = w[q][j]; const int c = 512 * j + 8 * F.lane;
                const f32x4 g0 = *(const f32x4*)(gnorm + c), g1 = *(const f32x4*)(gnorm + c + 4);
                const f32x4 v0 = {__uint_as_float(x.x << 16), __uint_as_float(x.x & 0xffff0000u), __uint_as_float(x.y << 16), __uint_as_float(x.y & 0xffff0000u)};
                const f32x4 v1 = {__uint_as_float(x.z << 16), __uint_as_float(x.z & 0xffff0000u), __uint_as_float(x.w << 16), __uint_as_float(x.w & 0xffff0000u)};
                yo[(c >> 2)] = v0 * rstd * g0; yo[(c >> 2) + 1] = v1 * rstd * g1; } }
    }
}

typedef float f32x16 __attribute__((ext_vector_type(16)));

__device__ __forceinline__ void attn_wave_qb(Frame& F, int ck, int head, int qb, bf16* Ob) {
    const int lane = F.lane, l31 = lane & 31, hi = lane >> 5, kvh = head >> 2;
    const bf16* Qb = (const bf16*)(F.ws + WS_Q); const bf16* KX = (const bf16*)(F.ws + WS_KX);
    int r0, kstart; const bf16* kbase; const bf16* vtb; size_t vstr;
    if (ck < 256) { const int b = ck >> 7, n = ck & 127; r0 = b * SEQ + 64 * n; kstart = 64 * (n - 2);
        kbase = KX + (size_t)(b * SEQ) * 128 + kvh * 64; vtb = (const bf16*)(F.ws + WS_VTP) + (size_t)((b * 2 + kvh) * 64) * SEQ; vstr = SEQ; }
    else { const int sb = ck - 256; r0 = MP + 64 * sb; kstart = 0; kbase = (const bf16*)(F.ws + WS_KXS) + (size_t)(sb * 192) * 128 + kvh * 64; vtb = (const bf16*)(F.ws + WS_VTS) + (size_t)((sb * 2 + kvh) * 64) * 192; vstr = 192; }
    const float sink = INP(28)[head] * 1.4426950408889634f;
    bf16x8 qf[4];
    const bf16* qrow = Qb + (size_t)(r0 + 32 * qb + l31) * 512 + head * 64 + 8 * hi;
#pragma unroll
    for (int s = 0; s < 4; ++s) qf[s] = *(const GAS bf16x8*)(qrow + 16 * s);
    f32x16 S[6];
#pragma unroll
    for (int kb = 0; kb < 6; ++kb) {
        const int k0 = kstart + 32 * kb; const bool valid = k0 >= 0; const int kc = valid ? k0 : 0;
        const bf16* krow = kbase + (size_t)(kc + l31) * 128 + 8 * hi;
        f32x16 a = {0.f, 0.f, 0.f, 0.f, 0.f, 0.f, 0.f, 0.f, 0.f, 0.f, 0.f, 0.f, 0.f, 0.f, 0.f, 0.f};
#pragma unroll
        for (int s = 0; s < 4; ++s) { const bf16x8 kf = *(const GAS bf16x8*)(krow + 16 * s); a = __builtin_amdgcn_mfma_f32_32x32x16_bf16(kf, qf[s], a, 0, 0, 0); }
#pragma unroll
        for (int r = 0; r < 16; ++r) S[kb][r] = valid ? a[r] : -1e30f;
    }
    float mx = sink;
#pragma unroll
    for (int kb = 0; kb < 6; ++kb)
#pragma unroll
        for (int r = 0; r < 16; ++r) mx = fmaxf(mx, S[kb][r]);
    mx = fmaxf(mx, __shfl_xor(mx, 32));
    float lsum = 0.f;
#pragma unroll
    for (int kb = 0; kb < 6; ++kb)
#pragma unroll
        for (int r = 0; r < 16; ++r) { const float e = __builtin_amdgcn_exp2f(S[kb][r] - mx); S[kb][r] = e; lsum += e; }
    lsum += __shfl_xor(lsum, 32);
    lsum += __builtin_amdgcn_exp2f(sink - mx);
    const float rl = 1.0f / lsum;
    f32x16 o[2];
#pragma unroll
    for (int db = 0; db < 2; ++db)
#pragma unroll
        for (int r = 0; r < 16; ++r) o[db][r] = 0.f;
#pragma unroll
    for (int kb = 0; kb < 6; ++kb) {
        const int k0 = kstart + 32 * kb; const int kc = k0 >= 0 ? k0 : 0;
#pragma unroll
        for (int s = 0; s < 2; ++s) {
            u32x4q pw; pw.x = pg8::cvt_pk_bf16(S[kb][8 * s + 0], S[kb][8 * s + 1]); pw.y = pg8::cvt_pk_bf16(S[kb][8 * s + 2], S[kb][8 * s + 3]);
            pw.z = pg8::cvt_pk_bf16(S[kb][8 * s + 4], S[kb][8 * s + 5]); pw.w = pg8::cvt_pk_bf16(S[kb][8 * s + 6], S[kb][8 * s + 7]);
            const bf16x8 pf = __builtin_bit_cast(bf16x8, pw);
#pragma unroll
            for (int db = 0; db < 2; ++db) {
                const bf16* vp = vtb + (size_t)(32 * db + l31) * vstr + kc + 16 * s + 4 * hi;
                const u32x2q v0 = *(const GAS u32x2q*)vp, v1 = *(const GAS u32x2q*)(vp + 8);
                u32x4q vw; vw.x = v0.x; vw.y = v0.y; vw.z = v1.x; vw.w = v1.y;
                o[db] = __builtin_amdgcn_mfma_f32_32x32x16_bf16(__builtin_bit_cast(bf16x8, vw), pf, o[db], 0, 0, 0);
            }
        }
    }
    bf16* orow = Ob + (size_t)(r0 + 32 * qb + l31) * 512 + head * 64;
#pragma unroll
    for (int db = 0; db < 2; ++db)
#pragma unroll
        for (int g4 = 0; g4 < 4; ++g4) { u32x2q w; w.x = pg8::cvt_pk_bf16(o[db][4 * g4 + 0] * rl, o[db][4 * g4 + 1] * rl); w.y = pg8::cvt_pk_bf16(o[db][4 * g4 + 2] * rl, o[db][4 * g4 + 3] * rl);
            *(GAS u32x2q*)(orow + 32 * db + 8 * g4 + 4 * hi) = w; }
}

constexpr int S5_UPITCH = 2064;

__device__ __forceinline__ void s5_stage_u(Frame& F, int g, int n0) {
    const unsigned char* S5UG = (const unsigned char*)(F.ws + WS_S5U);
#pragma unroll
    for (int k = 0; k < 4; ++k) { const int idx = F.tid + 512 * k, nl = idx >> 7, off = (idx & 127) * 16; int n = n0 + nl; n = n < NCH ? n : NCH - 1;
        const v4u v = *(const GAS v4u*)(S5UG + ((size_t)(g * NCH + n) * 2048 + off));
        *(LAS v4u*)(F.lds + RING_OFF + nl * S5_UPITCH + off) = v; }
}

__device__ __forceinline__ void s5_load_u(Frame& F, int g, int n0, v4u (&su)[4]) {
    const unsigned char* S5UG = (const unsigned char*)(F.ws + WS_S5U);
#pragma unroll
    for (int k = 0; k < 4; ++k) { const int idx = F.tid + 512 * k, nl = idx >> 7, off = (idx & 127) * 16; int n = n0 + nl; n = n < NCH ? n : NCH - 1;
        su[k] = *(const GAS v4u*)(S5UG + ((size_t)(g * NCH + n) * 2048 + off)); }
}
__device__ __forceinline__ void s5_store_u(Frame& F, const v4u (&su)[4]) {
#pragma unroll
    for (int k = 0; k < 4; ++k) { const int idx = F.tid + 512 * k, nl = idx >> 7, off = (idx & 127) * 16; *(LAS v4u*)(F.lds + RING_OFF + nl * S5_UPITCH + off) = su[k]; }
}
__device__ __forceinline__ void s5_phase_a(Frame& F) {
    if (F.vcu >= 256) return;
    const int lane = F.lane, fr = lane & 15, fq = lane >> 4, g = F.vcu >> 3, j = F.vcu & 7, nblk = j == 0 ? 3 : 2;
    const bf16* Min = (const bf16*)(F.ws + WS_MIN); float* G = (float*)(F.ws + WS_G);
    const bf16* arow = Min + (size_t)(g * 128 + F.wave * 16 + fr) * 1024 + 8 * fq;
    bf16x8 Af[32]; v4u su[4];
    s5_load_u(F, g, j * 16, su);
#pragma unroll
    for (int ks = 0; ks < 32; ++ks) Af[ks] = *(const GAS bf16x8*)(arow + 32 * ks);
    const LAS unsigned char* brow = F.lds + RING_OFF + fr * S5_UPITCH + 16 * fq;
#pragma unroll 1
    for (int b = 0; b < nblk; ++b) { const int n0 = (b < 2 ? j + 8 * b : 16) * 16;
        s5_store_u(F, su);
        if (b + 1 < nblk) s5_load_u(F, g, (b + 1 < 2 ? j + 8 : 16) * 16, su);
        LDS_WAIT(); __syncthreads();
        f32x4 acc0 = {0.f, 0.f, 0.f, 0.f}, acc1 = {0.f, 0.f, 0.f, 0.f};
#pragma unroll
        for (int ks = 0; ks < 32; ks += 2) { const bf16x8 b0 = *(const LAS bf16x8*)(brow + 64 * ks), b1 = *(const LAS bf16x8*)(brow + 64 * ks + 64);
            acc0 = __builtin_amdgcn_mfma_f32_16x16x32_bf16(Af[ks], b0, acc0, 0, 0, 0); acc1 = __builtin_amdgcn_mfma_f32_16x16x32_bf16(Af[ks + 1], b1, acc1, 0, 0, 0); }
        *(GAS f32x4*)(G + (size_t)(g * NCHP + n0 + fr) * 128 + F.wave * 16 + 4 * fq) = acc0 + acc1;
        __syncthreads();
    }
}

__device__ __forceinline__ void s5_scan_unit(Frame& F, int s, int g) {
    const int p = F.lane; const int nch = s < NB ? 128 : 1; const int n0 = s < NB ? s * 128 : 256 + (s - NB);
    const float* G = (const float*)(F.ws + WS_G); bf16* HP = (bf16*)(F.ws + WS_HP);
    float are, aim; { double lrd, lid, fre, fim, pr, pi; s5_param<false>(F, g, p, lrd, lid, fre, fim); s5_pow<false>(lrd, lid, 64, pr, pi); are = (float)pr; aim = (float)pi; }
    float hr = 0.f, hi = 0.f;
    if (s >= NB) { hr = INP(4)[((s - NB) * NG + g) * NP + p]; hi = INP(5)[((s - NB) * NG + g) * NP + p]; }
    const float* gp = G + (size_t)(g * NCHP + n0) * 128 + p; bf16* hp = HP + (size_t)(g * NCHP + n0) * 128 + p;
    if (nch == 1) { hp[0] = (bf16)f2bf(hr); hp[64] = (bf16)f2bf(hi); const float gr = gp[0], gi = gp[64]; const float nr = are * hr - aim * hi + gr, ni = are * hi + aim * hr + gi; hr = nr; hi = ni; }
    else {
#pragma unroll 1
        for (int nb = 0; nb < 128; nb += 64) { float gr[64], gi[64];
#pragma unroll
            for (int k = 0; k < 64; ++k) { gr[k] = gp[(size_t)(nb + k) * 128]; gi[k] = gp[(size_t)(nb + k) * 128 + 64]; }
#pragma unroll
            for (int k = 0; k < 64; ++k) { hp[(size_t)(nb + k) * 128] = (bf16)f2bf(hr); hp[(size_t)(nb + k) * 128 + 64] = (bf16)f2bf(hi);
                const float nr = are * hr - aim * hi + gr[k], ni = are * hi + aim * hr + gi[k]; hr = nr; hi = ni; } }
    }
    float* ore = F.out + (s < NB ? O_S5RP + (size_t)(s * NG + g) * NP : O_S5RS + (size_t)((s - NB) * NG + g) * NP);
    float* oim = F.out + (s < NB ? O_S5IP + (size_t)(s * NG + g) * NP : O_S5IS + (size_t)((s - NB) * NG + g) * NP);
    ore[p] = hr; oim[p] = hi;
}

__device__ __forceinline__ float gelu_tanh_f(float x) { const float u = 0.7978845608028654f * (x + 0.044715f * x * x * x); const float e = __builtin_amdgcn_exp2f(2.885390081777927f * u); return x * (1.0f - __builtin_amdgcn_rcpf(e + 1.0f)); }

constexpr int S5_KT_OFF = 16 * S5_UPITCH + 256, S5_KT_BYTES = 65 * 512;
template <bool SAMPLE_ONLY> __device__ __forceinline__ void s5_phase_c(Frame& F, int) {
    static_assert(!SAMPLE_ONLY, "the sample chunks are block 16 of the j == 0 workgroups");
    if (F.vcu >= 256) return;
    const int lane = F.lane, fr = lane & 15, fq = lane >> 4, q = F.wave, g = F.vcu >> 3, j = F.vcu & 7, nblk = j == 0 ? 3 : 2;
    const bf16* Kt = (const bf16*)(F.ws + WS_KT); const bf16* Mout = (const bf16*)(F.ws + WS_MOUT); const bf16* HP = (const bf16*)(F.ws + WS_HP); bf16* YS5 = (bf16*)(F.ws + WS_YS5);
    f32x4 acc[3][8];
    v4u su[4];
    {
        bf16x8 Mf[8][4];
#pragma unroll
        for (int i = 0; i < 8; ++i) { const bf16* mrow = Mout + ((size_t)(g * 64 + 8 * i + q) * GC + fr) * 128 + 8 * fq;
#pragma unroll
            for (int kk = 0; kk < 4; ++kk) Mf[i][kk] = *(const GAS bf16x8*)(mrow + 32 * kk); }
        { v4u sk[5];
#pragma unroll
          for (int k = 0; k < 5; ++k) { const int idx = F.tid + 512 * k; sk[k] = (idx < S5_KT_BYTES / 16) ? *(const GAS v4u*)((const unsigned char*)Kt + (size_t)g * S5_KT_BYTES + idx * 16) : (v4u){0u, 0u, 0u, 0u}; }
#pragma unroll
          for (int k = 0; k < 5; ++k) { const int idx = F.tid + 512 * k; if (idx < S5_KT_BYTES / 16) *(LAS v4u*)(F.lds + RING_OFF + S5_KT_OFF + idx * 16) = sk[k]; } }
        s5_load_u(F, g, j * 16, su); s5_store_u(F, su);
#pragma unroll
        for (int b = 0; b < 3; ++b) {
            if (b < nblk) { const int n0 = (b < 2 ? j + 8 * b : 16) * 16; int n = n0 + fr; n = n < NCHP ? n : NCHP - 1;
                const bf16* hrow = HP + (size_t)(g * NCHP + n) * 128 + 8 * fq;
                bf16x8 Hf[4];
#pragma unroll
                for (int kk = 0; kk < 4; ++kk) Hf[kk] = *(const GAS bf16x8*)(hrow + 32 * kk);
#pragma unroll
                for (int i = 0; i < 8; ++i) { acc[b][i] = (f32x4){0.f, 0.f, 0.f, 0.f};
#pragma unroll
                    for (int kk = 0; kk < 4; ++kk) acc[b][i] = __builtin_amdgcn_mfma_f32_16x16x32_bf16(Mf[i][kk], Hf[kk], acc[b][i], 0, 0, 0); } }
        }
    }
    const LAS unsigned char* brow = F.lds + RING_OFF + fr * S5_UPITCH + 16 * fq;
    const LAS unsigned char* kbase = F.lds + RING_OFF + S5_KT_OFF + ((q + 1 - (fq >> 1)) * 16 + fr) * 32 + 16 * (fq & 1);
#pragma unroll
    for (int b = 0; b < 3; ++b) {
        if (b < nblk) { const int n0 = (b < 2 ? j + 8 * b : 16) * 16;
            if (b > 0) s5_store_u(F, su);
            LDS_WAIT(); __syncthreads();
            bf16x8 Bf[32];
#pragma unroll
            for (int sp = 0; sp < 32; ++sp) Bf[sp] = *(const LAS bf16x8*)(brow + 64 * sp);
#pragma unroll
            for (int d = -3; d <= 28; ++d) {
                if (d >= 0 || 2 * d + q >= 0) {
                    const bf16x8 a = *(const LAS bf16x8*)(kbase + d * 1024);
#pragma unroll
                    for (int i = 0; i < 8; ++i) { const int sp = 4 * i - d;
                        if (sp >= 0 && sp <= 31) acc[b][i] = __builtin_amdgcn_mfma_f32_16x16x32_bf16(a, Bf[sp], acc[b][i], 0, 0, 0); }
                }
            }
            if (b + 1 < nblk) s5_load_u(F, g, (b + 1 < 2 ? j + 8 : 16) * 16, su);
            if (n0 + fr < NCH) {
#pragma unroll
                for (int i = 0; i < 8; ++i) { const int t = 8 * i + q;
                    const unsigned w0 = pg8::cvt_pk_bf16(gelu_tanh_f(acc[b][i][0]), gelu_tanh_f(acc[b][i][1])), w1 = pg8::cvt_pk_bf16(gelu_tanh_f(acc[b][i][2]), gelu_tanh_f(acc[b][i][3]));
                    u32x2q w; w.x = w0; w.y = w1;
                    *(GAS u32x2q*)(YS5 + ((size_t)((n0 + fr) * 64 + t) * S5W + g * GC + 4 * fq)) = w; } }
            __syncthreads();
        }
    }
}
enum TailKind { TK_RESID = 0, TK_MIX1 = 1, TK_MIX2 = 2 };
constexpr int TAIL_PITCH = 132;
constexpr int TAIL_LP = 528;
template <int KIND, int K, int NORM = 0> __device__ __forceinline__ void tail_gemm(Frame& F, const bf16* A, const bf16* Bt, const float* xs, bf16* H, const float* gate, float scale, int from_x, bf16* O, const bf16* Y,
                                                                                   const bf16* nHin = nullptr, bf16* nHout = nullptr, const float* gnorm = nullptr, const float* msh = nullptr, bf16* nXN = nullptr, float* nYF = nullptr,
                                                                                   float* npart = nullptr, unsigned* ncnt = nullptr, unsigned* ntmo = nullptr, unsigned nwant = 16u) {
    static_assert(K % 256 == 0, "K blocks of 256");
    constexpr int NKB = K / 256;
    const int lane = F.lane, fr = lane & 15, fq = lane >> 4, w = F.wave;
    for (int tile = F.vcu; tile < (MS / 32) * (DM / 64); tile += F.G) { const int rt = ((tile >> 5) & 1) * 8 + (tile & 7), ct = (tile >> 6) * 4 + ((tile >> 3) & 3), rb = w & 1, cb = w >> 1;
        const bf16* gp[6]; int lo[6];
#pragma unroll
        for (int i = 0; i < 6; ++i) { const int q = F.tid + 512 * i, row = q >> 5, p = q & 31;
            gp[i] = (row < 32 ? A + (size_t)(MP + rt * 32 + row) * K : Bt + (size_t)(ct * 64 + row - 32) * K) + p * 8; lo[i] = row * TAIL_LP + p * 16; }
        constexpr int NBUF = 4;
        v4u L[NBUF][6];
#pragma unroll
        for (int s = 0; s < NBUF; ++s)
#pragma unroll
            for (int i = 0; i < 6; ++i) L[s][i] = (s < NKB) ? *(const GAS v4u*)(gp[i] + s * 256) : (v4u){0u, 0u, 0u, 0u};
        constexpr int TAIL_BUF = 96 * TAIL_LP;
        f32x4 acc[2][4];
#pragma unroll
        for (int a = 0; a < 2; ++a)
#pragma unroll
            for (int c = 0; c < 4; ++c) acc[a][c] = (f32x4){0.f, 0.f, 0.f, 0.f};
        const LAS unsigned char* ab = F.lds + RING_OFF + fr * TAIL_LP + 64 * w + 16 * fq; const LAS unsigned char* bb = F.lds + RING_OFF + (32 + fr) * TAIL_LP + 64 * w + 16 * fq;
#pragma unroll
        for (int kb = 0; kb < NKB; ++kb) { const int bo = (kb & 1) * TAIL_BUF;
#pragma unroll
            for (int i = 0; i < 6; ++i) *(LAS v4u*)(F.lds + RING_OFF + bo + lo[i]) = L[kb % NBUF][i];
            if (kb + NBUF < NKB) {
#pragma unroll
                for (int i = 0; i < 6; ++i) L[kb % NBUF][i] = *(const GAS v4u*)(gp[i] + (kb + NBUF) * 256); }
            LDS_WAIT(); __syncthreads();
            bf16x8 af[2], bf[4];
#pragma unroll
            for (int a = 0; a < 2; ++a) af[a] = *(const LAS bf16x8*)(ab + bo + a * 16 * TAIL_LP);
#pragma unroll
            for (int c = 0; c < 4; ++c) bf[c] = *(const LAS bf16x8*)(bb + bo + c * 16 * TAIL_LP);
#pragma unroll
            for (int a = 0; a < 2; ++a)
#pragma unroll
                for (int c = 0; c < 4; ++c) acc[a][c] = __builtin_amdgcn_mfma_f32_16x16x32_bf16(bf[c], af[a], acc[a][c], 0, 0, 0);
        }
        __syncthreads();
#pragma unroll
        for (int a = 0; a < 2; ++a)
#pragma unroll
            for (int c = 0; c < 4; ++c) *(LAS f32x4*)(F.lds + RING_OFF + ((w * 8 + a * 4 + c) * 64 + lane) * 16) = acc[a][c];
        LDS_WAIT(); __syncthreads();
        f32x4 sum = {0.f, 0.f, 0.f, 0.f};
#pragma unroll
        for (int j = 0; j < 8; ++j) sum += *(const LAS f32x4*)(F.lds + RING_OFF + ((j * 8 + rb * 4 + cb) * 64 + lane) * 16);
        const int row = MP + rt * 32 + rb * 16 + fr, c0 = ct * 64 + 16 * cb + 4 * fq;
        if (KIND == TK_RESID) {
            const int s = NB + ((row - MP) >> 6);
            const f32x4 g0 = *(const f32x4*)(gate + (size_t)s * NMOD + c0) * scale;
            f32x4 base;
            if (from_x) base = *(const GAS f32x4*)(xs + (size_t)(row - MP) * DM + c0);
            else { const u32x2q bw = *(const GAS u32x2q*)((NORM ? nHin : H) + (size_t)row * DM + c0); base = (f32x4){__uint_as_float(bw.x << 16), __uint_as_float(bw.x & 0xffff0000u), __uint_as_float(bw.y << 16), __uint_as_float(bw.y & 0xffff0000u)}; }
            const f32x4 h = base + g0 * sum;
            if (NORM == 0) { u32x2q wv; wv.x = pg8::cvt_pk_bf16(h[0], h[1]); wv.y = pg8::cvt_pk_bf16(h[2], h[3]); *(GAS u32x2q*)(H + (size_t)row * DM + c0) = wv; }
            else {
                LAS float* red = (LAS float*)(F.lds + RING_OFF + 81920);
                float a = (h[0] * h[0] + h[1] * h[1]) + (h[2] * h[2] + h[3] * h[3]); a += __shfl_xor(a, 16); a += __shfl_xor(a, 32);
                if (fq == 0) red[w * 16 + fr] = a;
                __syncthreads();
                if (w == 0) {
                    if (lane < 32) { float p = 0.f;
#pragma unroll
                        for (int j = 0; j < 4; ++j) p += red[(2 * j + (lane >> 4)) * 16 + (lane & 15)];
                        __hip_atomic_store((gu32*)(npart + (size_t)(rt * 16 + ct) * 32 + lane), __float_as_uint(p), RLX_AGENT); }
                    VM_WAIT();
                    if (lane == 0) (void)__hip_atomic_fetch_add((gu32*)(ncnt + rt * 16), 1u, RLX_AGENT);
                }
                if (NORM == 1) { u32x2q wv; wv.x = pg8::cvt_pk_bf16(h[0], h[1]); wv.y = pg8::cvt_pk_bf16(h[2], h[3]); *(GAS u32x2q*)(nHout + (size_t)row * DM + c0) = wv; }
                f32x4 ga = *(const f32x4*)(gnorm + c0), sh = {0.f, 0.f, 0.f, 0.f};
                if (NORM == 1) { ga = ga * (*(const f32x4*)(msh + (size_t)s * NMOD + DM + c0) + 1.0f); sh = *(const f32x4*)(msh + (size_t)s * NMOD + c0); }
                if (w == 0) { pg8::nrm_wait((pg8::pgu32*)(ncnt + rt * 16), nwant, (pg8::pgu32*)ntmo);
                    if (lane < 32) { float t = 0.f;
#pragma unroll
                        for (int j = 0; j < 16; ++j) t += __uint_as_float(__hip_atomic_load((gu32*)(npart + (size_t)(rt * 16 + j) * 32 + lane), RLX_AGENT));
                        red[128 + lane] = 1.0f / sqrtf(t * (1.0f / DM) + RMS_EPS); } }
                __syncthreads();
                const float rs = red[128 + rb * 16 + fr];
                if (NORM == 2) *(GAS f32x4*)(nYF + (size_t)row * DM + c0) = h * rs * ga;
                else { const f32x4 y = h * rs * ga + sh; u32x2q wv; wv.x = pg8::cvt_pk_bf16(y[0], y[1]); wv.y = pg8::cvt_pk_bf16(y[2], y[3]); *(GAS u32x2q*)(nXN + (size_t)row * DM + c0) = wv; }
            }
        } else {
            bf16* op = O + (size_t)row * DM + c0; const u32x2q wv = *(const GAS u32x2q*)op;
            const f32x4 t = {__uint_as_float(wv.x << 16), __uint_as_float(wv.x & 0xffff0000u), __uint_as_float(wv.y << 16), __uint_as_float(wv.y & 0xffff0000u)}; f32x4 o;
            if (KIND == TK_MIX1) o = t * sum;
            else { const u32x2q gwv = *(const GAS u32x2q*)(Y + (size_t)row * DM + c0);
                const f32x4 gg = {__uint_as_float(gwv.x << 16), __uint_as_float(gwv.x & 0xffff0000u), __uint_as_float(gwv.y << 16), __uint_as_float(gwv.y & 0xffff0000u)}; o = t + gg * sum; }
            u32x2q r; r.x = pg8::cvt_pk_bf16(o[0], o[1]); r.y = pg8::cvt_pk_bf16(o[2], o[3]); *(GAS u32x2q*)op = r;
        }
        __syncthreads();
    }
}
constexpr int AT_K_BYTES = 192 * 256, AT_V_PITCH = 392, AT_V_OFF = AT_K_BYTES, AT_V_BYTES = 128 * AT_V_PITCH;
__device__ __forceinline__ void attn_chunk_lds(Frame& F, int ck, bf16* Ob) {
    const int lane = F.lane, l31 = lane & 31, hi = lane >> 5, head = F.wave, kvh = head >> 2;
    const int b = ck >> 7, n = ck & 127, wst = n >= 2 ? 64 * (n - 2) : 0, nvalid = 64 * (n + 1) - wst;
    const bf16* Qb = (const bf16*)(F.ws + WS_Q);
    const unsigned char* kg = (const unsigned char*)(F.ws + WS_KX) + (size_t)(b * SEQ + wst) * 256;
    const unsigned char* vg = (const unsigned char*)(F.ws + WS_VTP) + ((size_t)(b * 2) * 64 * SEQ + wst) * 2;
    { v4u kr[6];
#pragma unroll
      for (int k = 0; k < 6; ++k) { const int p = F.tid + 512 * k; kr[k] = *(const GAS v4u*)(kg + (size_t)p * 16); }
      v4u vr[6];
#pragma unroll
      for (int k = 0; k < 6; ++k) { const int p = F.tid + 512 * k, row = p / 24, pc = p % 24; vr[k] = *(const GAS v4u*)(vg + (size_t)row * (SEQ * 2) + pc * 16); }
#pragma unroll
      for (int k = 0; k < 6; ++k) { const int p = F.tid + 512 * k, row = p >> 4, ch = p & 15; *(LAS v4u*)(F.lds + RING_OFF + row * 256 + ((ch ^ (row & 15)) << 4)) = kr[k]; }
#pragma unroll
      for (int k = 0; k < 6; ++k) { const int p = F.tid + 512 * k, row = p / 24, pc = p % 24; LAS unsigned long long* d = (LAS unsigned long long*)(F.lds + RING_OFF + AT_V_OFF + row * AT_V_PITCH + pc * 16);
          d[0] = (unsigned long long)vr[k].x | ((unsigned long long)vr[k].y << 32); d[1] = (unsigned long long)vr[k].z | ((unsigned long long)vr[k].w << 32); }
    }
    const float sink = INP(28)[head] * 1.4426950408889634f;
    const int r0 = b * SEQ + 64 * n;
    bf16x8 qf[2][4];
#pragma unroll
    for (int qb = 0; qb < 2; ++qb) { const bf16* qrow = Qb + (size_t)(r0 + 32 * qb + l31) * 512 + head * 64 + 8 * hi;
#pragma unroll
        for (int s = 0; s < 4; ++s) qf[qb][s] = *(const GAS bf16x8*)(qrow + 16 * s); }
    LDS_WAIT(); __syncthreads();
    const LAS unsigned char* kl = F.lds + RING_OFF; const LAS unsigned char* vl = F.lds + RING_OFF + AT_V_OFF + (kvh * 64 + l31) * AT_V_PITCH + 8 * hi;
#pragma unroll 1
    for (int qb = 0; qb < 2; ++qb) {
        f32x16 S[6];
#pragma unroll
        for (int kb = 0; kb < 6; ++kb) {
            const int row = 32 * kb + l31;
            f32x16 a = {0.f, 0.f, 0.f, 0.f, 0.f, 0.f, 0.f, 0.f, 0.f, 0.f, 0.f, 0.f, 0.f, 0.f, 0.f, 0.f};
#pragma unroll
            for (int s = 0; s < 4; ++s) { const int ch = kvh * 8 + 2 * s + hi; const bf16x8 kf = *(const LAS bf16x8*)(kl + row * 256 + ((ch ^ (row & 15)) << 4));
                a = __builtin_amdgcn_mfma_f32_32x32x16_bf16(kf, qb ? qf[1][s] : qf[0][s], a, 0, 0, 0); }
            const bool valid = 32 * kb < nvalid;
#pragma unroll
            for (int r = 0; r < 16; ++r) S[kb][r] = valid ? a[r] : -1e30f;
        }
        float mx = sink;
#pragma unroll
        for (int kb = 0; kb < 6; ++kb)
#pragma unroll
            for (int r = 0; r < 16; ++r) mx = fmaxf(mx, S[kb][r]);
        mx = fmaxf(mx, __shfl_xor(mx, 32));
        float lsum = 0.f;
#pragma unroll
        for (int kb = 0; kb < 6; ++kb)
#pragma unroll
            for (int r = 0; r < 16; ++r) { const float e = __builtin_amdgcn_exp2f(S[kb][r] - mx); S[kb][r] = e; lsum += e; }
        lsum += __shfl_xor(lsum, 32);
        lsum += __builtin_amdgcn_exp2f(sink - mx);
        const float rl = 1.0f / lsum;
        f32x16 o[2];
#pragma unroll
        for (int db = 0; db < 2; ++db)
#pragma unroll
            for (int r = 0; r < 16; ++r) o[db][r] = 0.f;
#pragma unroll
        for (int kb = 0; kb < 6; ++kb)
#pragma unroll
            for (int s = 0; s < 2; ++s) {
                u32x4q pw; pw.x = pg8::cvt_pk_bf16(S[kb][8 * s + 0], S[kb][8 * s + 1]); pw.y = pg8::cvt_pk_bf16(S[kb][8 * s + 2], S[kb][8 * s + 3]);
                pw.z = pg8::cvt_pk_bf16(S[kb][8 * s + 4], S[kb][8 * s + 5]); pw.w = pg8::cvt_pk_bf16(S[kb][8 * s + 6], S[kb][8 * s + 7]);
                const bf16x8 pf = __builtin_bit_cast(bf16x8, pw);
#pragma unroll
                for (int db = 0; db < 2; ++db) {
                    const LAS unsigned char* vp = vl + db * 32 * AT_V_PITCH + (32 * kb + 16 * s) * 2;
                    const u32x2q v0 = *(const LAS u32x2q*)vp, v1 = *(const LAS u32x2q*)(vp + 16);
                    u32x4q vw; vw.x = v0.x; vw.y = v0.y; vw.z = v1.x; vw.w = v1.y;
                    o[db] = __builtin_amdgcn_mfma_f32_32x32x16_bf16(__builtin_bit_cast(bf16x8, vw), pf, o[db], 0, 0, 0);
                }
            }
        bf16* orow = Ob + (size_t)(r0 + 32 * qb + l31) * 512 + head * 64;
#pragma unroll
        for (int db = 0; db < 2; ++db)
#pragma unroll
            for (int g4 = 0; g4 < 4; ++g4) { u32x2q w; w.x = pg8::cvt_pk_bf16(o[db][4 * g4 + 0] * rl, o[db][4 * g4 + 1] * rl); w.y = pg8::cvt_pk_bf16(o[db][4 * g4 + 2] * rl, o[db][4 * g4 + 3] * rl);
                *(GAS u32x2q*)(orow + 32 * db + 8 * g4 + 4 * hi) = w; }
    }
    __syncthreads();
}
constexpr int NPH = 12;
__global__ void __launch_bounds__(NWAVES * 64, 2) mk_fwd(Args args) {
    extern __shared__ __attribute__((aligned(16))) unsigned char lds[];
    Frame F;
    F.lds = (LAS unsigned char*)lds; F.MISC = (volatile LAS unsigned*)(F.lds + MISC_OFF);
    F.tid = threadIdx.x; F.lane = F.tid & 63; F.wave = __builtin_amdgcn_readfirstlane(F.tid >> 6);
    F.G = gridDim.x; { const int bx = blockIdx.x; F.vcu = (F.G % 8 == 0) ? (bx % 8) * (F.G / 8) + bx / 8 : bx; }
    F.ap = (KArgs)__builtin_amdgcn_kernarg_segment_ptr();
    F.out = args.out; F.ws = args.ws; F.ctl = (gu32*)(args.ws + WS_CTL);
    for (int u = F.tid; u < (LDS_BYTES - LDSCTL_OFF) / 4; u += NWAVES * 64) ((LAS unsigned*)(F.lds + LDSCTL_OFF))[u] = 0u;
    __syncthreads();
    XcdBarrier bar; bar.bar = (unsigned*)(F.ctl + CW_BAR); bar.x = 0; bar.st = nullptr;
    if (MK_SINGLE) bar = xcd_barrier_post((unsigned*)(F.ctl + CW_BAR), F.MISC + 8);
    const int lo = args.ph_lo, hi = args.ph_hi;
#define IN(k) (lo <= (k) && (k) < hi)
#define SEAM(k) do { if (IN(k) && IN((k) + 1)) xcd_barrier(bar); } while (0)
#define PH_BEGIN(k) if (IN(k)) { LAUNDER_ARGS();
#define PH_END(k) } SEAM(k);
    unsigned char* ws = args.ws;
#define NPART(k) ((float*)(ws + WS_NPART) + (size_t)(k) * 73728)
#define NCNT(k) ((unsigned*)(ws + WS_CTL) + CW_NORM + (k) * 96 * 16)
#define NTMO ((unsigned*)(ws + WS_CTL) + CW_BAR + XB_TMO)
    const float* mod = (const float*)(ws + WS_MOD);

    PH_BEGIN(0) p0_prologue(F); xcd_barrier(bar); p0b_prologue(F); PH_END(0)
    PH_BEGIN(1)
        pg8::Gemm g{(const pg8::bf16_t*)(ws + WS_XN), (const pg8::bf16_t*)(ws + WS_W1I), M, 2 * FF, DM}; pg8::StaticOrder S; S.init(M, 2 * FF, F.G, (int)blockIdx.x);
        pg8::EpiSwiglu E{(pg8::bf16_t*)(ws + WS_A), FF};
        pg8::gemm_phase<pg8::EpiSwiglu, pg8::StaticOrder, true, true>(F.lds + RING_OFF, g, S, E);
        convert_idle(F, 1, (int)blockIdx.x, (M / 256) * (2 * FF / 256) - 5 * 256);
    PH_END(1)
    PH_BEGIN(2)
        pg8::Gemm g{(const pg8::bf16_t*)(ws + WS_A), (const pg8::bf16_t*)(ws + WS_W1O), MP, DM, FF}; pg8::StaticOrder S; S.init(MP, DM, F.G, (int)blockIdx.x);
        pg8::EpiResidNorm<1, 0> E{INP(0), INP(1), nullptr, (pg8::bf16_t*)F.out, mod + 2 * DM, INP(13), mod + 3 * DM, (pg8::bf16_t*)(ws + WS_XN), nullptr, NPART(0), NCNT(0), NTMO, (const pg8::bf16_t*)(ws + WS_A), 0.5f, 4u};
        pg8::gemm_phase<pg8::EpiResidNorm<1, 0>, pg8::StaticOrder, true, true>(F.lds + RING_OFF, g, S, E);
    PH_END(2)
    PH_BEGIN(3)
        hp_sample_init(F);
        pg8::Gemm g{(const pg8::bf16_t*)(ws + WS_XN), (const pg8::bf16_t*)(ws + WS_WIN), M, INW, DM}; pg8::StaticOrder S; S.init(M, INW, F.G, (int)blockIdx.x);
        pg8::EpiWin E{(pg8::bf16_t*)(ws + WS_S5U), (pg8::bf16_t*)(ws + WS_Q), (pg8::bf16_t*)(ws + WS_KX), (pg8::bf16_t*)(ws + WS_KXS), (pg8::bf16_t*)(ws + WS_VTP), (pg8::bf16_t*)(ws + WS_VTS), (pg8::bf16_t*)(ws + WS_GS5), (pg8::bf16_t*)(ws + WS_GATT),
                      INP(26), INP(27), (const float*)(ws + WS_ROPE), F.out, QSCALE};
        pg8::gemm_phase<pg8::EpiWin, pg8::StaticOrder, true, true>(F.lds + RING_OFF, g, S, E);
        convert_idle(F, 2, (int)blockIdx.x, (M / 256) * (INW / 256) - 3 * 256);
    PH_END(3)
    PH_BEGIN(4) s5_phase_a(F);
        if (F.wave == 7 && F.vcu >= 128) attn_wave_qb(F, 256 + ((F.vcu - 128) >> 4), ((F.vcu - 128) >> 1) & 7, F.vcu & 1, (bf16*)(ws + WS_Q));
    PH_END(4)
    PH_BEGIN(5)
        if (F.wave == 0 && (F.vcu & 3) == 0) s5_scan_unit(F, F.vcu >> 7, (F.vcu >> 2) & 31);
        else if (F.wave == 1) s5_scan_unit(F, NB + (F.vcu >> 5), F.vcu & 31);
        for (int ck = F.vcu; ck < 256; ck += F.G) attn_chunk_lds(F, ck, (bf16*)(ws + WS_Q));
    PH_END(5)
    PH_BEGIN(6) s5_phase_c<false>(F, 0); PH_END(6)
    PH_BEGIN(7)
        pg8::Gemm g{(const pg8::bf16_t*)(ws + WS_YS5), (const pg8::bf16_t*)(ws + WS_WGLU), M, 512, 512}; pg8::StaticOrder S; S.init(M, 512, F.G, (int)blockIdx.x);
        pg8::EpiMix<0> E{(pg8::bf16_t*)(ws + WS_Y2), (const pg8::bf16_t*)(ws + WS_YS5), INP(24), 512};
        pg8::gemm_phase<pg8::EpiMix<0>, pg8::StaticOrder, true, true>(F.lds + RING_OFF, g, S, E);
        convert_idle(F, 3, (int)blockIdx.x, (M / 256) * 2);
    PH_END(7)
    PH_BEGIN(8)
        pg8::Gemm g{(const pg8::bf16_t*)(ws + WS_Y2), (const pg8::bf16_t*)(ws + WS_WS5P), MP, DM, 512, (const pg8::bf16_t*)(ws + WS_Q), (const pg8::bf16_t*)(ws + WS_WAP)};
        pg8::ChainOrder S; S.init(MP, DM, F.G, (int)blockIdx.x);
        pg8::EpiProj E{(pg8::bf16_t*)(ws + WS_GS5), (const pg8::bf16_t*)(ws + WS_GATT)};
        pg8::gemm_phase<pg8::EpiProj, pg8::ChainOrder, true, true>(F.lds + RING_OFF, g, S, E);
        tail_gemm<TK_MIX1, 512>(F, (const bf16*)(ws + WS_Y2), (const bf16*)(ws + WS_WS5P), nullptr, nullptr, nullptr, 0.f, 0, (bf16*)(ws + WS_GS5), nullptr);
        VM_WAIT(); __syncthreads();
        tail_gemm<TK_MIX2, 512>(F, (const bf16*)(ws + WS_Q), (const bf16*)(ws + WS_WAP), nullptr, nullptr, nullptr, 0.f, 0, (bf16*)(ws + WS_GS5), (const bf16*)(ws + WS_GATT));
    PH_END(8)
    PH_BEGIN(9)
        pg8::Gemm g{(const pg8::bf16_t*)(ws + WS_GS5), (const pg8::bf16_t*)(ws + WS_WOUT), MP, DM, DM}; pg8::StaticOrder S; S.init(MP, DM, F.G, (int)blockIdx.x);
        pg8::EpiResidNorm<0, 0> E{nullptr, nullptr, (const pg8::bf16_t*)F.out, (pg8::bf16_t*)(ws + WS_GATT), mod + 5 * DM, INP(31), mod + 6 * DM, (pg8::bf16_t*)(ws + WS_XN), nullptr, NPART(1), NCNT(1), NTMO, (const pg8::bf16_t*)(ws + WS_GS5), 1.0f, 4u};
        pg8::gemm_phase<pg8::EpiResidNorm<0, 0>, pg8::StaticOrder, true, true>(F.lds + RING_OFF, g, S, E);
    PH_END(9)
    PH_BEGIN(10)
        pg8::Gemm g{(const pg8::bf16_t*)(ws + WS_XN), (const pg8::bf16_t*)(ws + WS_W2I), M, 2 * FF, DM}; pg8::StaticOrder S; S.init(M, 2 * FF, F.G, (int)blockIdx.x);
        pg8::EpiSwiglu E{(pg8::bf16_t*)(ws + WS_A), FF};
        pg8::gemm_phase<pg8::EpiSwiglu, pg8::StaticOrder, true, true>(F.lds + RING_OFF, g, S, E);
    PH_END(10)
    PH_BEGIN(11)
        pg8::Gemm g{(const pg8::bf16_t*)(ws + WS_A), (const pg8::bf16_t*)(ws + WS_W2O), MP, DM, FF}; pg8::StaticOrder S; S.init(MP, DM, F.G, (int)blockIdx.x);
        pg8::EpiResidNorm<0, 1> E{nullptr, nullptr, (const pg8::bf16_t*)(ws + WS_GATT), nullptr, mod + 8 * DM, INP(34), nullptr, nullptr, F.out, NPART(2), NCNT(2), NTMO, (const pg8::bf16_t*)(ws + WS_A), 0.5f, 4u};
        pg8::gemm_phase<pg8::EpiResidNorm<0, 1>, pg8::StaticOrder, true, true>(F.lds + RING_OFF, g, S, E);
    }
#undef IN
#undef SEAM
}

extern "C" void kernel_launch(void* const* d_in, const int* in_sizes, int n_in, void* d_out, int out_size, void* d_ws, size_t ws_size, hipStream_t stream) {
    static int grid = 0;
    if (grid == 0) {
        if (n_in != 35 || in_sizes[0] != MP * DM || (size_t)out_size != O_END || ws_size < WS_END) { fprintf(stderr, "kernel_launch: unexpected shapes: n_in %d in0 %d out %d ws %zu\n", n_in, n_in > 0 ? in_sizes[0] : -1, out_size, ws_size); grid = -1; return; }
        int dev = 0, cus = 0;
        if (hipGetDevice(&dev) != hipSuccess || hipDeviceGetAttribute(&cus, hipDeviceAttributeMultiprocessorCount, dev) != hipSuccess) { grid = -1; return; }
        if (hipFuncSetAttribute((const void*)mk_fwd, hipFuncAttributeMaxDynamicSharedMemorySize, LDS_BYTES) != hipSuccess) { fprintf(stderr, "kernel_launch: hipFuncSetAttribute failed\n"); grid = -1; return; }
        (void)hipGetLastError();
        if (cus != 256) { fprintf(stderr, "kernel_launch: this kernel's phase program assumes 256 CUs (got %d)\n", cus); grid = -1; return; }
        grid = cus;
    }
    if (grid < 0) return;
    if (hipMemsetAsync((char*)d_ws + WS_CTL, 0, CTL_ZERO_BYTES, stream) != hipSuccess) return;
    Args a{};
    for (int i = 0; i < 35; ++i) a.in[i] = (const float*)d_in[i];
    a.out = (float*)d_out; a.ws = (unsigned char*)d_ws;
    if (MK_SINGLE) { a.ph_lo = 0; a.ph_hi = NPH; a.li = 0; hipLaunchKernelGGL(mk_fwd, dim3(grid), dim3(NWAVES * 64), LDS_BYTES, stream, a); }
    else for (int ph = 0; ph < NPH; ++ph) { a.ph_lo = ph; a.ph_hi = ph + 1; a.li = 0; hipLaunchKernelGGL(mk_fwd, dim3(grid), dim3(NWAVES * 64), LDS_BYTES, stream, a); }
}
```

```cpp
#include <hip/hip_runtime.h>
#include <cstdio>
#include <cstdint>
namespace pg8 {
#define PG8_LAS __attribute__((address_space(3)))
typedef unsigned short bf16_t;
typedef short bf16x8 __attribute__((ext_vector_type(8)));
typedef float f32x4 __attribute__((ext_vector_type(4)));
typedef unsigned u32x4 __attribute__((ext_vector_type(4)));
constexpr int BM = 256, BK = 64, HALF = 128, HTB = HALF * BK * 2  , STAGE_BYTES = 8 * HTB, NXCD = 8, WGM = 4;

__host__ __device__ __forceinline__ int lds_byte(int r, int c) { const int st = (r >> 4) * 2 + (c >> 5), rr = r & 15, cc = c & 31, ob = rr * 64 + cc * 2; return st * 1024 + (ob ^ (((ob >> 9) & 1) << 5)); }
__host__ __device__ __forceinline__ void stage_rc(int b, int& R, int& C) { const int st = b / 1024, sb = b % 1024, swz = sb ^ (((sb >> 9) & 1) << 5); R = (st >> 1) * 16 + swz / 64; C = (st & 1) * 32 + (swz % 64) / 2; }
__host__ __device__ __forceinline__ int perm32(int rho) { const int n = rho >> 4, i = rho & 15; return 8 * (i >> 2) + 4 * n + (i & 3); }

struct Unit { int pm, pn, seg; };
struct Gemm { const bf16_t* A; const bf16_t* Bt; int M, N, K; const bf16_t* A2; const bf16_t* Bt2; int sclA = 0x7F7F7F7F, sclB = 0x7F7F7F7F; };

struct StaticOrder {
    int nM, nN, nwg, G, c;
    __host__ __device__ void init(int M, int N, int G_, int c_) { nM = M / BM; nN = N / BM; nwg = nM * nN; G = G_; c = c_; }
    __host__ __device__ bool next(int i, Unit& u) const {
        const long L = (long)i * G + c; if (L >= nwg) return false;
        int wgid = (int)L; { const int q = nwg / NXCD, r = nwg % NXCD, xcd = wgid % NXCD, off = wgid / NXCD; wgid = (xcd < r ? xcd * (q + 1) : r * (q + 1) + (xcd - r) * q) + off; }
        const int nig = WGM * nN, gid = wgid / nig, fm = gid * WGM, gsz = (nM - fm) < WGM ? (nM - fm) : WGM;
        u.pm = fm + ((wgid % nig) % gsz); u.pn = (wgid % nig) / gsz; u.seg = 0; return true;
    }
    __device__ __forceinline__ void a_ready(const Unit&) const {}
    __device__ __forceinline__ void done(const Unit&) const {}
};
__device__ __forceinline__ unsigned cvt_pk_bf16(float lo, float hi) { unsigned r; asm volatile("s_nop 0\n\tv_cvt_pk_bf16_f32 %0, %1, %2" : "=v"(r) : "v"(lo), "v"(hi)); return r; }
typedef float f32x2 __attribute__((ext_vector_type(2)));
constexpr int R_MP = 16384, R_M = 16896;
__device__ __forceinline__ float bf_lo(unsigned w) { return __uint_as_float(w << 16); }
__device__ __forceinline__ float bf_hi(unsigned w) { return __uint_as_float(w & 0xffff0000u); }
__device__ __forceinline__ float fast_sigmoid(float x) { return __builtin_amdgcn_rcpf(1.0f + __builtin_amdgcn_exp2f(-1.4426950408889634f * x)); }
__device__ __forceinline__ f32x4 vsigmoid(const f32x4 x) {
    const f32x4 t = x * -1.4426950408889634f; f32x4 e;
#pragma unroll
    for (int j = 0; j < 4; ++j) e[j] = __builtin_amdgcn_exp2f(t[j]);
    const f32x4 d = e + 1.0f; f32x4 r;
#pragma unroll
    for (int j = 0; j < 4; ++j) r[j] = __builtin_amdgcn_rcpf(d[j]);
    return r;
}
__device__ __forceinline__ u32x4 pack8(const f32x4 a, const f32x4 b) { u32x4 w; w.x = cvt_pk_bf16(a[0], a[1]); w.y = cvt_pk_bf16(a[2], a[3]); w.z = cvt_pk_bf16(b[0], b[1]); w.w = cvt_pk_bf16(b[2], b[3]); return w; }
__device__ __forceinline__ void unpack8(const u32x4 w, f32x4& a, f32x4& b) { a = (f32x4){bf_lo(w.x), bf_hi(w.x), bf_lo(w.y), bf_hi(w.y)}; b = (f32x4){bf_lo(w.z), bf_hi(w.z), bf_lo(w.w), bf_hi(w.w)}; }

typedef unsigned u32x2f __attribute__((ext_vector_type(2)));
__device__ __forceinline__ u32x2f pack8_fp8(const f32x4 a, const f32x4 b, const float sc) {
    u32x2f w; w.x = 0u; w.y = 0u;
    w.x = __builtin_amdgcn_cvt_pk_fp8_f32(a[0] * sc, a[1] * sc, w.x, false); w.x = __builtin_amdgcn_cvt_pk_fp8_f32(a[2] * sc, a[3] * sc, w.x, true);
    w.y = __builtin_amdgcn_cvt_pk_fp8_f32(b[0] * sc, b[1] * sc, w.y, false); w.y = __builtin_amdgcn_cvt_pk_fp8_f32(b[2] * sc, b[3] * sc, w.y, true);
    return w; }
struct EpiSwiglu {
    static constexpr bool PERM = true, AFTER_DRAIN = false, CHAIN = false, XTRA = false, F8 = true;
    unsigned char* O; int ldo;
    __device__ __forceinline__ void operator()(const f32x4 (&acc)[2][2][4][2], const Unit& u, int wr_, int wc_, int, int) const {
        int tid = threadIdx.x; asm volatile("" : "+v"(tid));
        const int fr = tid & 15, fq = (tid >> 4) & 3; int wr = wr_, wc = wc_; asm volatile("" : "+s"(wr), "+s"(wc));
        const int row0 = u.pm * BM + wr * 64 + fr, col0 = u.pn * HALF + wc * 32 + 8 * fq;
#pragma unroll
        for (int ai = 0; ai < 2; ++ai)
#pragma unroll
            for (int m = 0; m < 4; ++m) {
                f32x4 o[2];
#pragma unroll
                for (int n = 0; n < 2; ++n) { const f32x4 a = acc[ai][0][m][n] * (1.0f / 1024.0f), b = acc[ai][1][m][n] * (1.0f / 1024.0f); o[n] = a * vsigmoid(a) * b; }
                *(u32x2f*)(O + (size_t)(row0 + ai * HALF + m * 16) * ldo + col0) = pack8_fp8(o[0], o[1], 4.0f);
            }
    }
};

template <int FROM_X> struct EpiResid {
    static constexpr bool PERM = false, AFTER_DRAIN = false, CHAIN = false, XTRA = false, F8 = false;
    const float* xp; const float* xs; bf16_t* Hb; const float* gate;
    float scale; bf16_t* XN;
    typedef unsigned u32x2e __attribute__((ext_vector_type(2)));
    __device__ __forceinline__ void operator()(const f32x4 (&acc)[2][2][4][2], const Unit& u, int wr, int wc, int fr, int fq) const {
        const int col0 = u.pn * BM + wc * 32 + 4 * fq;
        bf16_t* outp = XN ? XN : Hb;
#pragma unroll
        for (int ai = 0; ai < 2; ++ai) {
            const int s = u.pm < 64 ? (u.pm >> 5) : 2 + (u.pm - 64) * 4 + ai * 2 + wr;
            f32x4 g[2][2];
#pragma unroll
            for (int bj = 0; bj < 2; ++bj)
#pragma unroll
                for (int n = 0; n < 2; ++n) g[bj][n] = *(const f32x4*)(gate + (size_t)s * 9216 + col0 + bj * HALF + n * 16) * scale;
#pragma unroll
            for (int mp = 0; mp < 2; ++mp) {
                f32x4 b[2][2][2];
#pragma unroll
                for (int mm = 0; mm < 2; ++mm) { const int r = u.pm * BM + ai * HALF + wr * 64 + (2 * mp + mm) * 16 + fr;
#pragma unroll
                    for (int bj = 0; bj < 2; ++bj)
#pragma unroll
                        for (int n = 0; n < 2; ++n) { const int c = col0 + bj * HALF + n * 16;
                            if (FROM_X) b[mm][bj][n] = *(const f32x4*)((r < R_MP ? xp + (size_t)r * 1024 : xs + (size_t)(r - R_MP) * 1024) + c);
                            else { const u32x2e w = *(const u32x2e*)(Hb + (size_t)r * 1024 + c); b[mm][bj][n] = (f32x4){bf_lo(w.x), bf_hi(w.x), bf_lo(w.y), bf_hi(w.y)}; } } }
                asm volatile("" ::: "memory");
#pragma unroll
                for (int mm = 0; mm < 2; ++mm) { const int m = 2 * mp + mm; const int r = u.pm * BM + ai * HALF + wr * 64 + m * 16 + fr;
#pragma unroll
                    for (int bj = 0; bj < 2; ++bj)
#pragma unroll
                        for (int n = 0; n < 2; ++n) { const f32x4 h = b[mm][bj][n] + g[bj][n] * acc[ai][bj][m][n];
                            u32x2e w; w.x = cvt_pk_bf16(h[0], h[1]); w.y = cvt_pk_bf16(h[2], h[3]); *(u32x2e*)(outp + (size_t)r * 1024 + col0 + bj * HALF + n * 16) = w; } }
                asm volatile("" ::: "memory");
            }
        }
    }
};

typedef __attribute__((address_space(1))) unsigned pgu32;
__device__ __forceinline__ void nrm_wait(pgu32* cnt, unsigned want, pgu32* tmo) {
    unsigned sp = 0;
    while ((unsigned)__builtin_amdgcn_readfirstlane(__hip_atomic_load(cnt, __ATOMIC_RELAXED, __HIP_MEMORY_SCOPE_AGENT)) != want) {
        __builtin_amdgcn_s_sleep(1);
        if ((++sp & 255u) == 0u) { if (__hip_atomic_load(tmo, __ATOMIC_RELAXED, __HIP_MEMORY_SCOPE_AGENT)) break; if (sp > (1u << 18)) { __hip_atomic_fetch_add(tmo, 1u, __ATOMIC_RELAXED, __HIP_MEMORY_SCOPE_AGENT); break; } }
    }
}
template <int FROM_X, int FINAL, bool F8_ = false, bool OUT8 = false> struct EpiResidNorm {
    static constexpr bool PERM = true, AFTER_DRAIN = true, CHAIN = false, XTRA = true, F8 = F8_;
    const float* xp; const float* xs; const bf16_t* Hin; bf16_t* Hout; const float* gate;
    const float* gnorm; const float* msh;
    bf16_t* XN; float* Y;
    float* part; unsigned* cnt; unsigned* tmo;
    const bf16_t* XA;
    unsigned char* XN8;
    float scale; unsigned want;
    __device__ __forceinline__ const bf16_t* xrows(const Unit& u, int K) const { return XA + (size_t)(R_MP + 8 * u.pm) * K; }
    __device__ __forceinline__ void operator()(const f32x4 (&)[2][2][4][2], const Unit&, int, int, int, int) const {}
    __device__ __forceinline__ void fused(f32x4 (&acc)[2][2][4][2], f32x4 (&xacc)[2], const Unit& u, int wr, int wc, int, int, PG8_LAS unsigned char* lds, int wid, int) const {
        int tid = threadIdx.x; asm volatile("" : "+v"(tid));
        const int fr = tid & 15, fq = (tid >> 4) & 3;
        const int s = u.pm >> 5, col0 = u.pn * BM + wc * 32 + 8 * fq, rowb = u.pm * BM + wr * 64 + fr;
        const int sx = 2 + (u.pm >> 3), colx = col0 + wr * HALF, rowx = R_MP + 8 * u.pm + (fr & 7); const bool vx = fr < 8;
        PG8_LAS float* red = (PG8_LAS float*)lds;
        float ss[2][4];
        {
            f32x4 g[2][2];
#pragma unroll
            for (int bj = 0; bj < 2; ++bj)
#pragma unroll
                for (int n = 0; n < 2; ++n) g[bj][n] = *(const f32x4*)(gate + (size_t)s * 9216 + col0 + bj * HALF + n * 4) * scale;
#pragma unroll
            for (int ai = 0; ai < 2; ++ai)
#pragma unroll
                for (int mp = 0; mp < 2; ++mp) {
                    f32x4 b[2][2][2];
#pragma unroll
                    for (int mm = 0; mm < 2; ++mm) { const int r = rowb + ai * HALF + (2 * mp + mm) * 16;
#pragma unroll
                        for (int bj = 0; bj < 2; ++bj) { const int c = col0 + bj * HALF;
                            if (FROM_X) { b[mm][bj][0] = *(const f32x4*)(xp + (size_t)r * 1024 + c); b[mm][bj][1] = *(const f32x4*)(xp + (size_t)r * 1024 + c + 4); }
                            else unpack8(*(const u32x4*)(Hin + (size_t)r * 1024 + c), b[mm][bj][0], b[mm][bj][1]); } }
                    asm volatile("" ::: "memory");
#pragma unroll
                    for (int mm = 0; mm < 2; ++mm) { const int m = 2 * mp + mm; float a = 0.f;
#pragma unroll
                        for (int bj = 0; bj < 2; ++bj)
#pragma unroll
                            for (int n = 0; n < 2; ++n) { const f32x4 h = b[mm][bj][n] + g[bj][n] * acc[ai][bj][m][n]; acc[ai][bj][m][n] = h; a += (h[0] * h[0] + h[1] * h[1]) + (h[2] * h[2] + h[3] * h[3]); }
                        ss[ai][m] = a; }
                    asm volatile("" :: "v"(ss[ai][2 * mp]), "v"(ss[ai][2 * mp + 1]) : "memory");
                }
        }
        {
            f32x4 b0, b1;
            if (FROM_X) { b0 = *(const f32x4*)(xs + (size_t)(rowx - R_MP) * 1024 + colx); b1 = *(const f32x4*)(xs + (size_t)(rowx - R_MP) * 1024 + colx + 4); }
            else unpack8(*(const u32x4*)(Hin + (size_t)rowx * 1024 + colx), b0, b1);
            const f32x4 g0 = *(const f32x4*)(gate + (size_t)sx * 9216 + colx) * scale, g1 = *(const f32x4*)(gate + (size_t)sx * 9216 + colx + 4) * scale;
            const f32x4 h0 = b0 + g0 * xacc[0], h1 = b1 + g1 * xacc[1]; xacc[0] = h0; xacc[1] = h1;
            float a = ((h0[0] * h0[0] + h0[1] * h0[1]) + (h0[2] * h0[2] + h0[3] * h0[3])) + ((h1[0] * h1[0] + h1[1] * h1[1]) + (h1[2] * h1[2] + h1[3] * h1[3]));
            a += __shfl_xor(a, 16); a += __shfl_xor(a, 32); if (fq == 0 && vx) red[1344 + wid * 8 + fr] = a;
        }
#pragma unroll
        for (int ai = 0; ai < 2; ++ai)
#pragma unroll
            for (int m = 0; m < 4; ++m) { float a = ss[ai][m]; a += __shfl_xor(a, 16); a += __shfl_xor(a, 32); if (fq == 0) red[wc * 256 + ai * HALF + wr * 64 + m * 16 + fr] = a; }
        __syncthreads();
        if (tid < 264) { float p;
            if (tid < 256) p = (red[tid] + red[256 + tid]) + (red[512 + tid] + red[768 + tid]);
            else { p = 0.f;
#pragma unroll
                for (int w8 = 0; w8 < 8; ++w8) p += red[1344 + w8 * 8 + (tid - 256)]; }
            __hip_atomic_store((pgu32*)(part + (size_t)(u.pm * 4 + u.pn) * 264 + tid), __float_as_uint(p), __ATOMIC_RELAXED, __HIP_MEMORY_SCOPE_AGENT); }
        asm volatile("s_waitcnt vmcnt(0)" ::: "memory");
        __syncthreads();
        if (tid == 0) (void)__hip_atomic_fetch_add((pgu32*)(cnt + u.pm * 16), 1u, __ATOMIC_RELAXED, __HIP_MEMORY_SCOPE_AGENT);
        if (!FINAL) {
#pragma unroll
            for (int ai = 0; ai < 2; ++ai)
#pragma unroll
                for (int m = 0; m < 4; ++m)
#pragma unroll
                    for (int bj = 0; bj < 2; ++bj) *(u32x4*)(Hout + (size_t)(rowb + ai * HALF + m * 16) * 1024 + col0 + bj * HALF) = pack8(acc[ai][bj][m][0], acc[ai][bj][m][1]);
            if (vx) *(u32x4*)(Hout + (size_t)rowx * 1024 + colx) = pack8(xacc[0], xacc[1]);
        }
        f32x4 ga[2][2], sh[2][2];
#pragma unroll
        for (int bj = 0; bj < 2; ++bj)
#pragma unroll
            for (int n = 0; n < 2; ++n) { const int c = col0 + bj * HALF + n * 4; ga[bj][n] = *(const f32x4*)(gnorm + c);
                if (!FINAL) { ga[bj][n] = ga[bj][n] * (*(const f32x4*)(msh + (size_t)s * 9216 + 1024 + c) + 1.0f); sh[bj][n] = *(const f32x4*)(msh + (size_t)s * 9216 + c); } }
        if (wid == 0) nrm_wait((pgu32*)(cnt + u.pm * 16), want, (pgu32*)tmo);
        __syncthreads();
        if (tid < 264) { float t = 0.f;
#pragma unroll
            for (int j = 0; j < 4; ++j) t += __uint_as_float(__hip_atomic_load((pgu32*)(part + (size_t)(u.pm * 4 + j) * 264 + tid), __ATOMIC_RELAXED, __HIP_MEMORY_SCOPE_AGENT));
            red[1024 + tid] = 1.0f / sqrtf(t * (1.0f / 1024.0f) + 1e-6f); }
        __syncthreads();
#pragma unroll
        for (int ai = 0; ai < 2; ++ai)
#pragma unroll
            for (int m = 0; m < 4; ++m) { const int rl = ai * HALF + wr * 64 + m * 16 + fr; const float rs = red[1024 + rl]; const size_t ro = (size_t)(u.pm * BM + rl) * 1024 + col0;
#pragma unroll
                for (int bj = 0; bj < 2; ++bj) {
                    if (FINAL) { *(f32x4*)(Y + ro + bj * HALF) = acc[ai][bj][m][0] * rs * ga[bj][0]; *(f32x4*)(Y + ro + bj * HALF + 4) = acc[ai][bj][m][1] * rs * ga[bj][1]; }
                    else { const f32x4 y0 = acc[ai][bj][m][0] * rs * ga[bj][0] + sh[bj][0], y1 = acc[ai][bj][m][1] * rs * ga[bj][1] + sh[bj][1];
                        if (OUT8) *(u32x2f*)((unsigned char*)XN + ro + bj * HALF) = pack8_fp8(y0, y1, 16.0f);
                        else { *(u32x4*)(XN + ro + bj * HALF) = pack8(y0, y1); if (XN8 != nullptr) *(u32x2f*)(XN8 + ro + bj * HALF) = pack8_fp8(y0, y1, 16.0f); } } } }
        {
            const float rs = red[1024 + 256 + (fr & 7)]; const size_t ro = (size_t)rowx * 1024 + colx;
            f32x4 a0 = *(const f32x4*)(gnorm + colx), a1 = *(const f32x4*)(gnorm + colx + 4);
            if (FINAL) { if (vx) { *(f32x4*)(Y + ro) = xacc[0] * rs * a0; *(f32x4*)(Y + ro + 4) = xacc[1] * rs * a1; } }
            else { const float* mp_ = msh + (size_t)sx * 9216;
                a0 = a0 * (*(const f32x4*)(mp_ + 1024 + colx) + 1.0f); a1 = a1 * (*(const f32x4*)(mp_ + 1024 + colx + 4) + 1.0f);
                const f32x4 s0 = *(const f32x4*)(mp_ + colx), s1 = *(const f32x4*)(mp_ + colx + 4);
                if (vx) { const f32x4 y0 = xacc[0] * rs * a0 + s0, y1 = xacc[1] * rs * a1 + s1;
                    if (OUT8) *(u32x2f*)((unsigned char*)XN + ro) = pack8_fp8(y0, y1, 16.0f);
                    else { *(u32x4*)(XN + ro) = pack8(y0, y1); if (XN8 != nullptr) *(u32x2f*)(XN8 + ro) = pack8_fp8(y0, y1, 16.0f); } } }
        }
    }
};

struct EpiGate {
    static constexpr bool PERM = true, AFTER_DRAIN = false, CHAIN = false, XTRA = false, F8 = true;
    bf16_t* GS5; bf16_t* GATT; bf16_t* Q; const float* qn; const float* rope; float qscale;
    __device__ __forceinline__ void operator()(const f32x4 (&acc)[2][2][4][2], const Unit& u, int wr_, int wc_, int, int) const {
        int tid = threadIdx.x; asm volatile("" : "+v"(tid));
        const int fr = tid & 15, fq = (tid >> 4) & 3; int wr = wr_, wc = wc_; asm volatile("" : "+s"(wr), "+s"(wc));
        const int rowt = u.pm * BM + wr * 64 + fr;
        if (u.pn < 8) {
            bf16_t* base = (u.pn < 4 ? GS5 : GATT) + (size_t)rowt * 1024 + (u.pn & 3) * 256 + wc * 32 + 8 * fq;
#pragma unroll
            for (int ai = 0; ai < 2; ++ai)
#pragma unroll
                for (int m = 0; m < 4; ++m)
#pragma unroll
                    for (int bj = 0; bj < 2; ++bj)
                        *(u32x4*)(base + (size_t)(ai * HALF + m * 16) * 1024 + bj * HALF) = pack8(vsigmoid(acc[ai][bj][m][0] * (1.0f / 1024.0f)), vsigmoid(acc[ai][bj][m][1] * (1.0f / 1024.0f)));
            return;
        }
        const int head = (u.pn - 8) * 4 + wc;
        f32x4 gw[2][2];
#pragma unroll
        for (int bj = 0; bj < 2; ++bj)
#pragma unroll
            for (int n = 0; n < 2; ++n) gw[bj][n] = *(const f32x4*)(qn + 32 * bj + 8 * fq + 4 * n);
#pragma unroll
        for (int ai = 0; ai < 2; ++ai)
#pragma unroll
            for (int m = 0; m < 4; ++m) {
                const int r = rowt + ai * HALF + m * 16;
                const int pos = r < R_MP ? (r & 8191) : 2048 + ((r - R_MP) & 63);
                float ss = 0.f;
#pragma unroll
                for (int bj = 0; bj < 2; ++bj)
#pragma unroll
                    for (int n = 0; n < 2; ++n) { const f32x4 x = acc[ai][bj][m][n]; ss += (x[0] * x[0] + x[1] * x[1]) + (x[2] * x[2] + x[3] * x[3]); }
                ss += __shfl_xor(ss, 16); ss += __shfl_xor(ss, 32);
                const float rn = (1.0f / 1024.0f) / sqrtf(ss * (1.0f / (64.0f * 1024.0f * 1024.0f)) + 1e-6f);
                f32x4 v[2][2];
#pragma unroll
                for (int bj = 0; bj < 2; ++bj)
#pragma unroll
                    for (int n = 0; n < 2; ++n) v[bj][n] = acc[ai][bj][m][n] * rn * gw[bj][n];
#pragma unroll
                for (int n = 0; n < 2; ++n) {
                    const f32x4 cs = *(const f32x4*)(rope + (size_t)pos * 16 + 4 * n), sn = *(const f32x4*)(rope + (size_t)pos * 16 + 8 + 4 * n);
                    f32x4 pr;
#pragma unroll
                    for (int j = 0; j < 4; ++j) pr[j] = __shfl_xor(v[0][n][j], 16);
                    if (fq == 0) v[0][n] = v[0][n] * cs - pr * sn;
                    else if (fq == 1) v[0][n] = v[0][n] * cs + pr * sn;
                }
                bf16_t* rowp = Q + (size_t)r * 512 + head * 64 + 8 * fq;
#pragma unroll
                for (int bj = 0; bj < 2; ++bj) *(u32x4*)(rowp + 32 * bj) = pack8(v[bj][0] * qscale, v[bj][1] * qscale);
            }
    }
};

struct EpiWin {
    static constexpr bool PERM = true, AFTER_DRAIN = false, CHAIN = false, XTRA = false, F8 = false;
    bf16_t *S5U, *Q, *KX, *KXS, *VTP, *VTS, *GS5, *GATT;
    const float *qn, *kn, *rope;
    float* out;
    float qscale;
    __device__ __forceinline__ void operator()(const f32x4 (&acc)[2][2][4][2], const Unit& u, int wr, int wc, int fr_, int fq_) const {
        int fr = fr_, fq = fq_; asm volatile("" : "+v"(fr), "+v"(fq));
        const int pn = u.pn == 2 ? 4 : u.pn, rowt = u.pm * BM + wr * 64 + fr;
        if (pn < 2) {
#pragma unroll
            for (int ai = 0; ai < 2; ++ai)
#pragma unroll
                for (int m = 0; m < 4; ++m) { const int r = rowt + ai * HALF + m * 16, nchk = r >> 6, sp = r & 63;
#pragma unroll
                    for (int bj = 0; bj < 2; ++bj) { const int col = pn * 256 + bj * HALF + wc * 32 + 8 * fq, g = col >> 4, c0 = col & 15;
                        *(u32x4*)(S5U + ((size_t)((g * 264 + nchk) * 64 + sp) * 16 + c0)) = pack8(acc[ai][bj][m][0], acc[ai][bj][m][1]); } }
            return;
        }
        if (pn >= 5) {
            bf16_t* base; int ld, cb; bool sig;
            if (pn < 9) { base = GS5; ld = 1024; cb = (pn - 5) * 256; sig = true; }
            else { base = GATT; ld = 1024; cb = (pn - 9) * 256; sig = true; }
            const int col0 = cb + wc * 32 + 8 * fq;
#pragma unroll
            for (int ai = 0; ai < 2; ++ai)
#pragma unroll
                for (int m = 0; m < 4; ++m) { bf16_t* rowp = base + (size_t)(rowt + ai * HALF + m * 16) * ld + col0;
#pragma unroll
                    for (int bj = 0; bj < 2; ++bj) { f32x4 v0 = acc[ai][bj][m][0], v1 = acc[ai][bj][m][1];
                        if (sig) { v0 = vsigmoid(v0); v1 = vsigmoid(v1); }
                        *(u32x4*)(rowp + bj * HALF) = pack8(v0, v1); } }
            return;
        }
        const bool isv = (pn == 4) && (wc >= 2);
        if (!isv) {
            const bool isq = pn < 4;
            const int head = isq ? (pn - 2) * 4 + wc : wc;
            const float* gn = isq ? qn : kn;
            f32x4 gw[2][2];
#pragma unroll
            for (int bj = 0; bj < 2; ++bj)
#pragma unroll
                for (int n = 0; n < 2; ++n) gw[bj][n] = *(const f32x4*)(gn + 32 * bj + 8 * fq + 4 * n);
#pragma unroll
            for (int ai = 0; ai < 2; ++ai)
#pragma unroll
                for (int m = 0; m < 4; ++m) {
                    const int r = rowt + ai * HALF + m * 16;
                    const int pos = r < R_MP ? (r & 8191) : 2048 + ((r - R_MP) & 63);
                    float ss = 0.f;
#pragma unroll
                    for (int bj = 0; bj < 2; ++bj)
#pragma unroll
                        for (int n = 0; n < 2; ++n) { const f32x4 x = acc[ai][bj][m][n]; ss += (x[0] * x[0] + x[1] * x[1]) + (x[2] * x[2] + x[3] * x[3]); }
                    ss += __shfl_xor(ss, 16); ss += __shfl_xor(ss, 32);
                    const float rn = 1.0f / sqrtf(ss * (1.0f / 64.0f) + 1e-6f);
                    f32x4 v[2][2];
#pragma unroll
                    for (int bj = 0; bj < 2; ++bj)
#pragma unroll
                        for (int n = 0; n < 2; ++n) v[bj][n] = acc[ai][bj][m][n] * rn * gw[bj][n];
#pragma unroll
                    for (int n = 0; n < 2; ++n) {
                        const f32x4 cs = *(const f32x4*)(rope + (size_t)pos * 16 + 4 * n), sn = *(const f32x4*)(rope + (size_t)pos * 16 + 8 + 4 * n);
                        f32x4 pr;
#pragma unroll
                        for (int j = 0; j < 4; ++j) pr[j] = __shfl_xor(v[0][n][j], 16);
                        if (fq == 0) v[0][n] = v[0][n] * cs - pr * sn;
                        else if (fq == 1) v[0][n] = v[0][n] * cs + pr * sn;
                    }
                    if (isq) {
                        bf16_t* rowp = Q + (size_t)r * 512 + head * 64 + 8 * fq;
#pragma unroll
                        for (int bj = 0; bj < 2; ++bj) *(u32x4*)(rowp + 32 * bj) = pack8(v[bj][0] * qscale, v[bj][1] * qscale);
                    } else {
                        bf16_t* rowp = (r < R_MP ? KX + (size_t)r * 128 : KXS + (size_t)(((r - R_MP) >> 6) * 192 + 128 + ((r - R_MP) & 63)) * 128) + head * 64 + 8 * fq;
#pragma unroll
                        for (int bj = 0; bj < 2; ++bj) *(u32x4*)(rowp + 32 * bj) = pack8(v[bj][0], v[bj][1]);
                        float* wp = nullptr;
                        if (r < R_MP) { if (pos >= 8064) wp = out + 17301504 + (size_t)(((r >> 13) * 128 + (pos - 8064)) * 2 + head) * 64; }
                        else wp = out + 17375232 + (size_t)((((r - R_MP) >> 6) * 128 + 64 + ((r - R_MP) & 63)) * 2 + head) * 64;
                        if (wp) {
#pragma unroll
                            for (int bj = 0; bj < 2; ++bj)
#pragma unroll
                                for (int n = 0; n < 2; ++n) *(f32x4*)(wp + 32 * bj + 8 * fq + 4 * n) = v[bj][n];
                        }
                    }
                }
        } else {
            const int head = wc - 2;
#pragma unroll
            for (int ai = 0; ai < 2; ++ai)
#pragma unroll
                for (int m = 0; m < 4; ++m) {
                    const int r = rowt + ai * HALF + m * 16;
                    bf16_t* vt; size_t vstr; float* wp = nullptr;
                    if (r < R_MP) { const int b = r >> 13, pos = r & 8191; vt = VTP + (size_t)((b * 2 + head) * 64) * 8192 + pos; vstr = 8192;
                        if (pos >= 8064) wp = out + 17334272 + (size_t)((b * 128 + (pos - 8064)) * 2 + head) * 64; }
                    else { const int sb = (r - R_MP) >> 6, t = (r - R_MP) & 63; vt = VTS + (size_t)((sb * 2 + head) * 64) * 192 + 128 + t; vstr = 192;
                        wp = out + 17506304 + (size_t)((sb * 128 + 64 + t) * 2 + head) * 64; }
#pragma unroll
                    for (int bj = 0; bj < 2; ++bj)
#pragma unroll
                        for (int n = 0; n < 2; ++n) { const f32x4 x = acc[ai][bj][m][n]; const int d0 = 32 * bj + 8 * fq + 4 * n;
                            const unsigned w0 = cvt_pk_bf16(x[0], x[1]), w1 = cvt_pk_bf16(x[2], x[3]);
                            vt[(size_t)(d0 + 0) * vstr] = (bf16_t)(w0 & 0xffffu); vt[(size_t)(d0 + 1) * vstr] = (bf16_t)(w0 >> 16);
                            vt[(size_t)(d0 + 2) * vstr] = (bf16_t)(w1 & 0xffffu); vt[(size_t)(d0 + 3) * vstr] = (bf16_t)(w1 >> 16);
                            if (wp) *(f32x4*)(wp + d0) = x; }
                }
        }
    }
};

template <int MODE> struct EpiMix {
    static constexpr bool PERM = true, AFTER_DRAIN = false, CHAIN = false, XTRA = false, F8 = false;
    bf16_t* O; const bf16_t* Y; const float* bias; int ld;
    __device__ __forceinline__ void operator()(const f32x4 (&acc)[2][2][4][2], const Unit& u, int wr, int wc, int fr, int fq) const {
        const int row0 = u.pm * BM + wr * 64 + fr, col0 = u.pn * BM + wc * 32 + 8 * fq;
#pragma unroll
        for (int ai = 0; ai < 2; ++ai)
#pragma unroll
            for (int m = 0; m < 4; ++m) { const size_t off = (size_t)(row0 + ai * HALF + m * 16) * ld + col0;
#pragma unroll
                for (int bj = 0; bj < 2; ++bj) {
                    const f32x4 a0 = acc[ai][bj][m][0], a1 = acc[ai][bj][m][1]; f32x4 o0, o1;
                    if (MODE == 0) { f32x4 y0, y1; unpack8(*(const u32x4*)(Y + off + bj * HALF), y0, y1);
                        const f32x4 b0 = *(const f32x4*)(bias + col0 + bj * HALF), b1 = *(const f32x4*)(bias + col0 + bj * HALF + 4);
                        o0 = y0 * vsigmoid(a0 + b0); o1 = y1 * vsigmoid(a1 + b1); }
                    else if (MODE == 1) { f32x4 g0, g1; unpack8(*(const u32x4*)(O + off + bj * HALF), g0, g1); o0 = g0 * a0; o1 = g1 * a1; }
                    else { f32x4 t0, t1, g0, g1; unpack8(*(const u32x4*)(O + off + bj * HALF), t0, t1); unpack8(*(const u32x4*)(Y + off + bj * HALF), g0, g1); o0 = t0 + g0 * a0; o1 = t1 + g1 * a1; }
                    if (MODE == 0) *(u32x2f*)((unsigned char*)O + off + bj * HALF) = pack8_fp8(o0, o1, 16.0f);
                    else *(u32x4*)(O + off + bj * HALF) = pack8(o0, o1); } }
    }
};

struct EpiProj {
    static constexpr bool PERM = true, AFTER_DRAIN = false, CHAIN = true, XTRA = true, F8 = true;
    const bf16_t* GS5; const bf16_t* GATT; unsigned char* OUT8;
    const bf16_t* XA0; const bf16_t* XA1;
    __device__ __forceinline__ const bf16_t* xrows(const Unit& u, int K) const { return (u.seg ? XA1 : XA0) + (size_t)(R_MP + 8 * u.pm) * K; }
    __device__ __forceinline__ void mid(f32x4 (&acc)[2][2][4][2], f32x4 (&xacc)[2], const Unit& u, int wr, int wc, int fr, int fq) const {
        const int row0 = u.pm * BM + wr * 64 + fr, col0 = u.pn * BM + wc * 32 + 8 * fq;
#pragma unroll
        for (int ai = 0; ai < 2; ++ai)
#pragma unroll
            for (int m = 0; m < 4; ++m) { const size_t off = (size_t)(row0 + ai * HALF + m * 16) * 1024 + col0;
#pragma unroll
                for (int bj = 0; bj < 2; ++bj) { f32x4 s0, s1, a0, a1; unpack8(*(const u32x4*)(GS5 + off + bj * HALF), s0, s1); unpack8(*(const u32x4*)(GATT + off + bj * HALF), a0, a1);
#pragma unroll
                    for (int j = 0; j < 4; ++j) { s0[j] *= __builtin_amdgcn_rcpf(fmaxf(a0[j], 1e-30f)); s1[j] *= __builtin_amdgcn_rcpf(fmaxf(a1[j], 1e-30f)); }
                    acc[ai][bj][m][0] *= s0; acc[ai][bj][m][1] *= s1; } }
        { const size_t off = (size_t)(R_MP + 8 * u.pm + (fr & 7)) * 1024 + col0 + wr * HALF; f32x4 s0, s1, a0, a1;
          unpack8(*(const u32x4*)(GS5 + off), s0, s1); unpack8(*(const u32x4*)(GATT + off), a0, a1);
#pragma unroll
          for (int j = 0; j < 4; ++j) { s0[j] *= __builtin_amdgcn_rcpf(fmaxf(a0[j], 1e-30f)); s1[j] *= __builtin_amdgcn_rcpf(fmaxf(a1[j], 1e-30f)); }
          xacc[0] *= s0; xacc[1] *= s1; }
    }
    __device__ __forceinline__ void operator()(const f32x4 (&acc)[2][2][4][2], const f32x4 (&xacc)[2], const Unit& u, int wr, int wc, int fr, int fq) const {
        const int row0 = u.pm * BM + wr * 64 + fr, col0 = u.pn * BM + wc * 32 + 8 * fq;
#pragma unroll
        for (int ai = 0; ai < 2; ++ai)
#pragma unroll
            for (int m = 0; m < 4; ++m) { const size_t off = (size_t)(row0 + ai * HALF + m * 16) * 1024 + col0;
#pragma unroll
                for (int bj = 0; bj < 2; ++bj) { f32x4 a0, a1; unpack8(*(const u32x4*)(GATT + off + bj * HALF), a0, a1);
                    *(u32x2f*)(OUT8 + off + bj * HALF) = pack8_fp8(a0 * acc[ai][bj][m][0], a1 * acc[ai][bj][m][1], 16.0f / 1024.0f); } }
        if (fr < 8) { const size_t off = (size_t)(R_MP + 8 * u.pm + fr) * 1024 + col0 + wr * HALF; f32x4 a0, a1; unpack8(*(const u32x4*)(GATT + off), a0, a1);
            *(u32x2f*)(OUT8 + off) = pack8_fp8(a0 * xacc[0], a1 * xacc[1], 16.0f / 1024.0f); }
    }
};
struct ChainOrder : StaticOrder {
    __host__ __device__ bool next(int i, Unit& u) const { if (!StaticOrder::next(i >> 1, u)) return false; u.seg = i & 1; return true; }
};
typedef int pg8_v4i __attribute__((ext_vector_type(4))); typedef int pg8_v8i __attribute__((ext_vector_type(8)));
template <class Epi, class Sched, bool ALIGN_EPI = false, bool SP2 = false>
__device__ __forceinline__ void gemm_phase(PG8_LAS unsigned char* lds, const Gemm g, const Sched& S, const Epi& E) {
    const int tid = threadIdx.x, wid = __builtin_amdgcn_readfirstlane(tid >> 6), lane = tid & 63, wr = wid >> 2, wc = wid & 3, fr = lane & 15, fq = lane >> 4;
    const int K = g.K, nt = K / BK;
    unsigned voffA[2], voffB[2];
#pragma unroll
    for (int i = 0; i < 2; ++i) { int R, C; stage_rc(tid * 16 + i * 8192, R, C); const int Rb = Epi::PERM ? ((R & ~31) + perm32(R & 31)) : R;
        voffA[i] = (unsigned)(R * K + C) * 2u; voffB[i] = (unsigned)(Rb * K + C) * 2u; }
    const size_t kstep = (size_t)(BK * 2);
    const size_t hstep = (size_t)HALF * K * 2;
    const size_t tstep = 2 * hstep;
    const unsigned ldsw = (unsigned)wid * 1024u;
    const int aoff = lds_byte(wr * 64 + fr, fq * 8), boff = lds_byte(wc * 32 + fr, fq * 8);
#define PG8_SA(b, h) (((b) * 2 + (h)) * HTB)
#define PG8_SB(b, h) ((4 + (b) * 2 + (h)) * HTB)
#define PG8_STAGE(bufoff, gbase, voff) do { _Pragma("unroll") for (int _i = 0; _i < 2; ++_i) \
        __builtin_amdgcn_global_load_lds((const unsigned*)((const char*)(gbase) + (voff)[_i]), (PG8_LAS unsigned*)(lds + (bufoff) + ldsw + _i * 8192), 16, 0, 0); } while (0)
#define PG8_LDA(dst, b, h) do { _Pragma("unroll") for (int m = 0; m < 4; ++m) _Pragma("unroll") for (int k = 0; k < 2; ++k) dst[m][k] = *(const PG8_LAS bf16x8*)(lds + PG8_SA(b, h) + aoff + m * 2048 + k * 1024); } while (0)
#define PG8_LDB(dst, b, h) do { _Pragma("unroll") for (int n = 0; n < 2; ++n) _Pragma("unroll") for (int k = 0; k < 2; ++k) dst[n][k] = *(const PG8_LAS bf16x8*)(lds + PG8_SB(b, h) + boff + n * 2048 + k * 1024); } while (0)
#define PG8_CAT(x0, x1) __builtin_shufflevector(__builtin_bit_cast(pg8_v4i, x0), __builtin_bit_cast(pg8_v4i, x1), 0, 1, 2, 3, 4, 5, 6, 7)
#define PG8_MMA(ai, bj, At, Bt) do { __builtin_amdgcn_s_setprio(1); \
        if constexpr (Epi::F8) { _Pragma("unroll") for (int m = 0; m < 4; ++m) _Pragma("unroll") for (int n = 0; n < 2; ++n) \
            { const pg8_v8i _b = PG8_CAT(Bt[n][0], Bt[n][1]), _a = PG8_CAT(At[m][0], At[m][1]); asm volatile("v_mfma_f32_16x16x128_f8f6f4 %0, %1, %2, %0" : "+v"(acc[ai][bj][m][n]) : "v"(_b), "v"(_a)); } } \
        else { _Pragma("unroll") for (int m = 0; m < 4; ++m) _Pragma("unroll") for (int n = 0; n < 2; ++n) _Pragma("unroll") for (int k = 0; k < 2; ++k) \
            acc[ai][bj][m][n] = __builtin_amdgcn_mfma_f32_16x16x32_bf16(Bt[n][k], At[m][k], acc[ai][bj][m][n], 0, 0, 0); } \
        __builtin_amdgcn_s_setprio(0); } while (0)
#define PG8_WAIT_V(n) asm volatile("s_waitcnt vmcnt(" #n ")" ::: "memory")
#define PG8_WAIT_L(n) asm volatile("s_waitcnt lgkmcnt(" #n ")" ::: "memory")
#define PG8_BAR __builtin_amdgcn_s_barrier()
#define PG8_SCHED __builtin_amdgcn_sched_barrier(0)
    Unit cur, nxt; int ui = 0;
    if (!S.next(0, cur)) return;
    f32x4 acc[2][2][4][2];
#pragma unroll
    for (int a = 0; a < 2; ++a)
#pragma unroll
        for (int b = 0; b < 2; ++b)
#pragma unroll
            for (int m = 0; m < 4; ++m)
#pragma unroll
                for (int n = 0; n < 2; ++n) acc[a][b][m][n] = (f32x4){0.f, 0.f, 0.f, 0.f};
    bf16x8 At[4][2], B0[2][2], B1[2][2];
    constexpr int XOFF = STAGE_BYTES + 4096, XPITCH = 144, XBUF = 8 * XPITCH;
    [[maybe_unused]] f32x4 xacc[2]; [[maybe_unused]] bf16x8 xs[2]; [[maybe_unused]] const char* xg = nullptr; [[maybe_unused]] const char* xgn = nullptr;
#define PG8_XLOAD(tt) do { const bool _nx = (tt) >= nt; const int _t = !_nx ? (tt) : (xgn ? (tt) - nt : nt - 1); const char* _g = (_nx && xgn) ? xgn : xg; \
        if (lane < 8) __builtin_amdgcn_global_load_lds((const unsigned*)(_g + (size_t)_t * kstep), (PG8_LAS unsigned*)(lds + XOFF + (_t & 3) * XBUF + wid * XPITCH), 16, 0, 0); } while (0)
#define PG8_XLDS(tt) do { _Pragma("unroll") for (int k = 0; k < 2; ++k) xs[k] = *(const PG8_LAS bf16x8*)(lds + XOFF + ((tt) & 3) * XBUF + (fr & 7) * XPITCH + k * 64 + fq * 16); } while (0)
#define PG8_XM1(Bx) do { if constexpr (Epi::F8) { _Pragma("unroll") for (int n = 0; n < 2; ++n) xacc[n] = __builtin_amdgcn_mfma_scale_f32_16x16x128_f8f6f4(PG8_CAT(Bx[n][0], Bx[n][1]), PG8_CAT(xs[0], xs[1]), xacc[n], 0, 0, 0, 0, 0, 0); } \
        else { _Pragma("unroll") for (int n = 0; n < 2; ++n) _Pragma("unroll") for (int k = 0; k < 2; ++k) xacc[n] = __builtin_amdgcn_mfma_f32_16x16x32_bf16(Bx[n][k], xs[k], xacc[n], 0, 0, 0); } } while (0)
#define PG8_XMMA() do { if (wr == 0) PG8_XM1(B0); else PG8_XM1(B1); } while (0)
    if constexpr (Epi::XTRA) { static_assert(SP2, "XTRA: SP2 loop only"); xacc[0] = (f32x4){0.f, 0.f, 0.f, 0.f}; xacc[1] = (f32x4){0.f, 0.f, 0.f, 0.f};
        xg = (const char*)E.xrows(cur, K) + ((size_t)wid * K + 8 * (lane & 7)) * 2; PG8_XLOAD(0); PG8_XLOAD(1); }
    const char* cA = (const char*)((Epi::CHAIN && cur.seg) ? g.A2 : g.A) + (size_t)cur.pm * tstep; const char* cB = (const char*)((Epi::CHAIN && cur.seg) ? g.Bt2 : g.Bt) + (size_t)cur.pn * tstep;
    S.a_ready(cur);
    if constexpr (SP2) {
        PG8_STAGE(PG8_SB(0, 0), cB, voffB); PG8_STAGE(PG8_SB(0, 1), cB + hstep, voffB); PG8_STAGE(PG8_SA(0, 0), cA, voffA); PG8_STAGE(PG8_SA(0, 1), cA + hstep, voffA);
        if (wr == 1) PG8_BAR;
        PG8_WAIT_V(2); PG8_BAR;
        PG8_STAGE(PG8_SB(1, 0), cB + kstep, voffB); PG8_STAGE(PG8_SA(1, 0), cA + kstep, voffA); PG8_STAGE(PG8_SB(1, 1), cB + hstep + kstep, voffB);
        PG8_WAIT_V(6); PG8_BAR;
    } else {
        PG8_STAGE(PG8_SB(0, 0), cB, voffB); PG8_STAGE(PG8_SA(0, 0), cA, voffA); PG8_STAGE(PG8_SB(0, 1), cB + hstep, voffB); PG8_STAGE(PG8_SA(0, 1), cA + hstep, voffA);
        if (wr == 1) PG8_BAR;
        PG8_WAIT_V(4); PG8_BAR;
        PG8_STAGE(PG8_SB(1, 0), cB + kstep, voffB); PG8_STAGE(PG8_SA(1, 0), cA + kstep, voffA); PG8_STAGE(PG8_SB(1, 1), cB + hstep + kstep, voffB);
        PG8_WAIT_V(6); PG8_BAR;
    }
    for (;;) {
        const bool has_next = S.next(ui + 1, nxt);
        if constexpr (Epi::XTRA) xgn = has_next ? (const char*)E.xrows(nxt, K) + ((size_t)wid * K + 8 * (lane & 7)) * 2 : nullptr;
        const char* nA = has_next ? (const char*)((Epi::CHAIN && nxt.seg) ? g.A2 : g.A) + (size_t)nxt.pm * tstep : cA; const char* nB = has_next ? (const char*)((Epi::CHAIN && nxt.seg) ? g.Bt2 : g.Bt) + (size_t)nxt.pn * tstep : cB;
#pragma unroll 1
        for (int t = 0; t < nt; t += 2) {
            const bool last = (t == nt - 2);
            const char* a1 = cA + (size_t)(t + 1) * kstep;
            const char* a2 = last ? nA : cA + (size_t)(t + 2) * kstep; const char* b2 = last ? nB : cB + (size_t)(t + 2) * kstep;
            const char* a3 = a2 + kstep; const char* b3 = b2 + kstep;
            if (last && has_next) S.a_ready(nxt);
            if constexpr (SP2) {
            PG8_LDB(B0, 0, 0); PG8_LDB(B1, 0, 1); PG8_SCHED; PG8_LDA(At, 0, 0); PG8_STAGE(PG8_SA(1, 1), a1 + hstep, voffA);
            if constexpr (Epi::XTRA) PG8_WAIT_V(9); else PG8_WAIT_V(8); PG8_WAIT_L(0); PG8_BAR; PG8_MMA(0, 0, At, B0); PG8_MMA(0, 1, At, B1); PG8_BAR; PG8_SCHED;
            PG8_LDA(At, 0, 1); if constexpr (Epi::XTRA) PG8_XLDS(t); PG8_STAGE(PG8_SB(0, 0), b2, voffB); PG8_STAGE(PG8_SB(0, 1), b2 + hstep, voffB); PG8_STAGE(PG8_SA(0, 0), a2, voffA);
            if constexpr (Epi::XTRA) PG8_WAIT_V(9); else PG8_WAIT_V(8); PG8_WAIT_L(0); PG8_BAR; PG8_MMA(1, 0, At, B0); PG8_MMA(1, 1, At, B1); if constexpr (Epi::XTRA) PG8_XMMA(); PG8_BAR; if constexpr (Epi::XTRA) PG8_XLOAD(t + 2); PG8_SCHED;
            PG8_LDB(B0, 1, 0); PG8_LDB(B1, 1, 1); PG8_SCHED; PG8_LDA(At, 1, 0); PG8_STAGE(PG8_SA(0, 1), a2 + hstep, voffA);
            if constexpr (Epi::XTRA) PG8_WAIT_V(9); else PG8_WAIT_V(8); PG8_WAIT_L(0); PG8_BAR; PG8_MMA(0, 0, At, B0); PG8_MMA(0, 1, At, B1); PG8_BAR; PG8_SCHED;
            PG8_LDA(At, 1, 1); if constexpr (Epi::XTRA) PG8_XLDS(t + 1); PG8_STAGE(PG8_SB(1, 0), b3, voffB); PG8_STAGE(PG8_SB(1, 1), b3 + hstep, voffB); PG8_STAGE(PG8_SA(1, 0), a3, voffA);
            if constexpr (Epi::XTRA) PG8_WAIT_V(9); else PG8_WAIT_V(8); PG8_WAIT_L(0); PG8_BAR; PG8_MMA(1, 0, At, B0); PG8_MMA(1, 1, At, B1); if constexpr (Epi::XTRA) PG8_XMMA(); PG8_BAR; if constexpr (Epi::XTRA) PG8_XLOAD(t + 3); PG8_SCHED;
            } else {
            PG8_LDB(B0, 0, 0); PG8_SCHED; PG8_LDA(At, 0, 0); PG8_STAGE(PG8_SA(1, 1), a1 + hstep, voffA);
            PG8_WAIT_L(8); PG8_BAR; PG8_WAIT_L(0); PG8_MMA(0, 0, At, B0); PG8_BAR; PG8_SCHED;
            PG8_LDB(B1, 0, 1); PG8_STAGE(PG8_SB(0, 0), b2, voffB);
            PG8_BAR; PG8_WAIT_L(0); PG8_MMA(0, 1, At, B1); PG8_BAR;
            PG8_LDA(At, 0, 1); PG8_STAGE(PG8_SA(0, 0), a2, voffA);
            PG8_BAR; PG8_WAIT_L(0); PG8_MMA(1, 0, At, B0); PG8_BAR; PG8_SCHED;
            PG8_STAGE(PG8_SB(0, 1), b2 + hstep, voffB);
            PG8_WAIT_V(6); PG8_BAR; PG8_MMA(1, 1, At, B1); PG8_BAR;
            PG8_LDB(B0, 1, 0); PG8_SCHED; PG8_LDA(At, 1, 0); PG8_STAGE(PG8_SA(0, 1), a2 + hstep, voffA);
            PG8_WAIT_L(8); PG8_BAR; PG8_WAIT_L(0); PG8_MMA(0, 0, At, B0); PG8_BAR; PG8_SCHED;
            PG8_LDB(B1, 1, 1); PG8_STAGE(PG8_SB(1, 0), b3, voffB);
            PG8_BAR; PG8_WAIT_L(0); PG8_MMA(0, 1, At, B1); PG8_BAR;
            PG8_LDA(At, 1, 1); PG8_STAGE(PG8_SA(1, 0), a3, voffA);
            PG8_BAR; PG8_WAIT_L(0); PG8_MMA(1, 0, At, B0); PG8_BAR; PG8_SCHED;
            PG8_STAGE(PG8_SB(1, 1), b3 + hstep, voffB);
            PG8_WAIT_V(6); PG8_BAR; PG8_MMA(1, 1, At, B1); PG8_BAR;
            }
        }
        if constexpr (ALIGN_EPI) { if (wr == 0) PG8_BAR; }
        if constexpr (!Epi::AFTER_DRAIN && Epi::XTRA) { static_assert(Epi::CHAIN, "XTRA without AFTER_DRAIN: chained units only"); if (cur.seg == 0) E.mid(acc, xacc, cur, wr, wc, fr, fq); else E(acc, xacc, cur, wr, wc, fr, fq); S.done(cur); }
        else if constexpr (!Epi::AFTER_DRAIN) { if constexpr (Epi::CHAIN) { if (cur.seg == 0) E.mid(acc, cur, wr, wc, fr, fq); else E(acc, cur, wr, wc, fr, fq); } else E(acc, cur, wr, wc, fr, fq); S.done(cur); }
        if (!has_next) break;
        if (!(Epi::CHAIN && cur.seg == 0))
#pragma unroll
        for (int a = 0; a < 2; ++a)
#pragma unroll
            for (int b = 0; b < 2; ++b)
#pragma unroll
                for (int m = 0; m < 4; ++m)
#pragma unroll
                    for (int n = 0; n < 2; ++n) acc[a][b][m][n] = (f32x4){0.f, 0.f, 0.f, 0.f};
        if constexpr (Epi::XTRA) { if (!(Epi::CHAIN && cur.seg == 0)) { xacc[0] = (f32x4){0.f, 0.f, 0.f, 0.f}; xacc[1] = (f32x4){0.f, 0.f, 0.f, 0.f}; } xg = xgn; }
        cur = nxt; cA = nA; cB = nB; ++ui;
        if constexpr (ALIGN_EPI) { if (wr == 1) PG8_BAR; }
    }
    PG8_WAIT_V(0);
    if constexpr (!ALIGN_EPI) { if (wr == 0) PG8_BAR; }
    PG8_BAR;
    if constexpr (Epi::AFTER_DRAIN) { if constexpr (Epi::XTRA) E.fused(acc, xacc, cur, wr, wc, fr, fq, lds, wid, lane); else E.fused(acc, cur, wr, wc, fr, fq, lds, wid, lane); S.done(cur); }
#undef PG8_XLOAD
#undef PG8_XLDS
#undef PG8_XMMA
#undef PG8_XM1
#undef PG8_CAT
#undef PG8_SA
#undef PG8_SB
#undef PG8_STAGE
#undef PG8_LDA
#undef PG8_LDB
#undef PG8_MMA
#undef PG8_WAIT_V
#undef PG8_WAIT_L
#undef PG8_BAR
#undef PG8_SCHED
}
}
#define GAS __attribute__((address_space(1)))
#define LAS __attribute__((address_space(3)))
typedef unsigned short bf16;
typedef unsigned v4u __attribute__((ext_vector_type(4)));
typedef float f32x4 __attribute__((ext_vector_type(4)));
typedef short bf16x8 __attribute__((ext_vector_type(8)));
typedef GAS unsigned gu32;
typedef GAS unsigned long long gu64;
#define RLX_AGENT __ATOMIC_RELAXED, __HIP_MEMORY_SCOPE_AGENT
#define LDS_WAIT() asm volatile("s_waitcnt lgkmcnt(0)" ::: "memory")
#define VM_WAIT() asm volatile("s_waitcnt vmcnt(0)" ::: "memory")
__device__ __forceinline__ unsigned long long rt() { return __builtin_amdgcn_s_memrealtime(); }
__device__ __forceinline__ unsigned f2bf(float f) { unsigned u = __builtin_bit_cast(unsigned, f); return (u + 0x7fffu + ((u >> 16) & 1u)) >> 16; }
__device__ __forceinline__ unsigned pk2(float lo, float hi) { return f2bf(lo) | (f2bf(hi) << 16); }

#define XB_TMO      128
#define XB_XCNT(j)  (256  + 64 * (j))
#define XB_XSUB(j)  (1280 + 64 * (j))
#define XB_XGEN(j)  (2304 + 64 * (j))
#define XB_TOP      3328
#define XB_TOPGEN   3392
#define XCD_BAR_WORDS 3456
#define XB_SPIN_CAP (1u << 18)

__device__ __forceinline__ unsigned xb_ld(unsigned* p)              { return __hip_atomic_load(p, __ATOMIC_RELAXED, __HIP_MEMORY_SCOPE_AGENT); }
__device__ __forceinline__ unsigned xb_add(unsigned* p, unsigned v) { return __hip_atomic_fetch_add(p, v, __ATOMIC_RELAXED, __HIP_MEMORY_SCOPE_AGENT); }
__device__ __forceinline__ unsigned xb_xcc_id() { return (unsigned)__builtin_amdgcn_s_getreg((3 << 11) | 20) & 0xFu; }
#define XB_SPIN(cond, bar) do { unsigned _sp = 0; while (cond) { __builtin_amdgcn_s_sleep(1); \
    if ((++_sp & 255u) == 0u) { if (xb_ld(&(bar)[XB_TMO])) break; if (_sp > XB_SPIN_CAP) { atomicAdd(&(bar)[XB_TMO], 1u); break; } } } } while (0)

struct XcdBarrier {
    unsigned* bar; unsigned x;
    volatile LAS unsigned* st;
};

__device__ __forceinline__ XcdBarrier xcd_barrier_post(unsigned* bar, volatile LAS unsigned* st) {
    XcdBarrier b; b.bar = bar; b.x = xb_xcc_id(); b.st = st;
    if (threadIdx.x == 0) (void)xb_add(&bar[XB_XCNT(b.x)], 1u);
    return b;
}
__device__ __forceinline__ void xcd_barrier_complete(unsigned* bar, unsigned x, unsigned& nloc, unsigned& nx) {
    const unsigned G = gridDim.x * gridDim.y * gridDim.z;
    unsigned sum, cnt, mine, sp = 0u;
    for (;;) {
        sum = 0u; cnt = 0u; mine = 0u;
#pragma unroll
        for (unsigned j = 0; j < 16; ++j) { const unsigned c = xb_ld(&bar[XB_XCNT(j)]); sum += c; cnt += (c > 0u) ? 1u : 0u; mine = (j == x) ? c : mine; }
        if (sum == G) break;
        __builtin_amdgcn_s_sleep(1);
        if ((++sp & 255u) == 0u) { if (xb_ld(&bar[XB_TMO])) break; if (sp > XB_SPIN_CAP) { atomicAdd(&bar[XB_TMO], 1u); break; } }
    }
    nloc = mine > 0u ? mine : 1u; nx = cnt > 0u ? cnt : 1u;
}

__device__ __forceinline__ void xcd_barrier(const XcdBarrier& b) {
    asm volatile("s_waitcnt vmcnt(0)" ::: "memory");
    __syncthreads();
    if (threadIdx.x == 0) {
        unsigned* bar = b.bar;
        __builtin_amdgcn_s_waitcnt(0);
        unsigned nloc = b.st[0], nx = b.st[1];
        if (nloc == 0u) { xcd_barrier_complete(bar, b.x, nloc, nx); b.st[0] = nloc; b.st[1] = nx; }
        const unsigned old = xb_add(&bar[XB_XSUB(b.x)], 1u);
        const unsigned gen = old / nloc;
        if (old + 1u == (gen + 1u) * nloc) {
            __builtin_amdgcn_fence(__ATOMIC_RELEASE, "agent");
            __builtin_amdgcn_fence(__ATOMIC_ACQUIRE, "agent");
            asm volatile("s_waitcnt vmcnt(0)" ::: "memory");
            const unsigned og = xb_add(&bar[XB_TOP], 1u);
            const unsigned tg = og / nx;
            if (og + 1u == (tg + 1u) * nx) {
#pragma unroll
                for (unsigned j = 0; j < 16; ++j) xb_add(&bar[XB_XGEN(j)], 1u);
            }
        } else {
            __builtin_amdgcn_fence(__ATOMIC_ACQUIRE, "agent");
            asm volatile("s_waitcnt vmcnt(0)" ::: "memory");
        }
        XB_SPIN(xb_ld(&bar[XB_XGEN(b.x)]) == gen, bar);
    }
    __syncthreads();
}
typedef unsigned u32x4q __attribute__((ext_vector_type(4))); typedef unsigned u32x2q __attribute__((ext_vector_type(2)));
constexpr int NWAVES = 8;
#ifndef MK_SINGLE
#define MK_SINGLE 1
#endif
constexpr int DM = 1024, SEQ = 8192, NB = 2, DB = 8, DSEQ = 64, PAST = 2048, FF = 2816;
constexpr int MP = NB * SEQ, MS = DB * DSEQ, M = MP + MS;
constexpr int NSTREAM = NB + DB;
constexpr int NG = 32, GC = 16, NP = 64, S5W = 512, QW = 512, INW = 3328, NMOD = 9216;
constexpr int KXROWS = MP + DB * 192;
constexpr float RMS_EPS = 1e-6f;
constexpr float QSCALE = 0.125f * 1.4426950408889634f;
constexpr size_t O_Y = 0, O_KWP = 17301504, O_VWP = 17334272, O_S5RP = 17367040, O_S5IP = 17371136, O_KWS = 17375232, O_VWS = 17506304, O_S5RS = 17637376, O_S5IS = 17653760, O_END = 17670144;
constexpr size_t MiB = 1u << 20;
constexpr size_t WS_CTL = 0, CTL_ZERO_BYTES = 64 * 1024;
constexpr size_t WS_KXS = 64 * 1024, WS_VTS = 448 * 1024;
constexpr size_t WS_MOD = 2 * MiB + 576 * 1024;
constexpr size_t WS_NPART = 3 * MiB;
constexpr size_t WS_ROPE = 2 * MiB + 64 * 1024;
constexpr size_t WS_W1I = 4 * MiB, WS_W1O = 15 * MiB, WS_W2I = 20 * MiB + 512 * 1024, WS_W2O = 31 * MiB + 512 * 1024, WS_WIN = 37 * MiB, WS_WGLU = 43 * MiB + 512 * 1024, WS_WS5P = 44 * MiB, WS_WAP = 45 * MiB, WS_WOUT = 46 * MiB;
constexpr size_t WS_WIN8 = 37 * MiB + 3 * MiB;
constexpr size_t WS_XN8 = 83 * MiB + 62 * MiB;
constexpr size_t WS_MRG8 = 50 * MiB + (size_t)16896 * 1024;
constexpr size_t WS_O8 = 50 * MiB;
constexpr size_t WS_XN = 50 * MiB;
constexpr size_t WS_A = 83 * MiB;
constexpr size_t WS_S5U = WS_A, WS_Q = WS_A + 17 * MiB, WS_KX = WS_A + 34 * MiB, WS_VTP = WS_A + 39 * MiB, WS_YS5 = WS_A + 44 * MiB, WS_Y2 = WS_A + 61 * MiB;
constexpr size_t WS_GS5 = 174 * MiB, WS_GATT = 207 * MiB;
constexpr size_t WS_KT = 48 * MiB;
constexpr size_t WS_G = WS_A + 80 * MiB;
constexpr size_t WS_HP = WS_A + 85 * MiB;
constexpr size_t WS_MIN = 240 * MiB, WS_MOUT = 248 * MiB, WS_END = 256 * MiB;
constexpr int NCH = 264, NCHP = 272;

static_assert(WS_W1I + (size_t)2 * FF * DM * 2 <= WS_W1O && WS_W1O + (size_t)DM * FF * 2 <= WS_W2I && WS_W2I + (size_t)2 * FF * DM * 2 <= WS_W2O && WS_W2O + (size_t)DM * FF * 2 <= WS_WIN, "ws map 1");
static_assert(WS_WIN + (size_t)INW * DM * 2 <= WS_WGLU && WS_WOUT + (size_t)DM * DM * 2 <= WS_KT && WS_KT + (size_t)NG * 65 * 512 <= WS_XN && WS_XN + (size_t)M * DM * 2 <= WS_A && WS_A + (size_t)M * FF * 2 <= WS_GS5, "ws map 2");
static_assert(WS_S5U + (size_t)M * 512 * 2 <= WS_Q && WS_Q + (size_t)M * 512 * 2 <= WS_KX && WS_KX + (size_t)MP * 128 * 2 <= WS_VTP && WS_VTP + (size_t)4 * MiB <= WS_YS5, "ws map 3");
static_assert(WS_YS5 + (size_t)M * 512 * 2 <= WS_Y2 && WS_Y2 + (size_t)M * 512 * 2 <= WS_GS5 && WS_GS5 + (size_t)M * DM * 2 <= WS_GATT && WS_GATT + (size_t)M * DM * 2 <= WS_MIN, "ws map 4");
constexpr int CW_TMO = 0, CW_CODE = 1, CW_WORK = 64, CW_BAR = 4096, CW_NORM = 8192, CW_ADA = 13312;
constexpr int RING_OFF = 0, RING_BYTES = 131072, LDSCTL_OFF = RING_BYTES, MISC_OFF = LDSCTL_OFF + 320, LDS_BYTES = 147456;

struct Args { const float* in[35]; float* out; unsigned char* ws; int ph_lo, ph_hi, li, pad; };
typedef const __attribute__((address_space(4))) Args* KArgs;
struct Frame {
    LAS unsigned char* lds; volatile LAS unsigned* MISC; gu32* ctl;
    int tid, lane, wave, vcu, G;
    KArgs ap; float* out; unsigned char* ws;
};
#define INP(k) (F.ap->in[k])
#define LAUNDER_ARGS() asm volatile("" : "+s"(F.ap))
__device__ __forceinline__ float wave_sum(float v) {
#pragma unroll
    for (int o = 1; o < 64; o <<= 1) v += __shfl_xor(v, o);
    return v;
}
__device__ __forceinline__ float bf2f(bf16 x) { return __uint_as_float((unsigned)x << 16); }
__device__ __forceinline__ int row_stream(int r) { return r < MP ? (r >> 13) : 2 + ((r - MP) >> 6); }

__device__ __forceinline__ void sincos_d(double x, double& s, double& c) {
    const double q = rint(x * 0.63661977236758134308);
    double r = fma(-q, 1.57079632673412561417e+00, x); r = fma(-q, 6.07710050650619224932e-11, r);
    const double r2 = r * r;
    double sp = 1.0 / 6227020800.0; sp = fma(sp, r2, -1.0 / 39916800.0); sp = fma(sp, r2, 1.0 / 362880.0); sp = fma(sp, r2, -1.0 / 5040.0); sp = fma(sp, r2, 1.0 / 120.0); sp = fma(sp, r2, -1.0 / 6.0);
    const double sr = fma(r * r2, sp, r);
    double cp = -1.0 / 87178291200.0; cp = fma(cp, r2, 1.0 / 479001600.0); cp = fma(cp, r2, -1.0 / 3628800.0); cp = fma(cp, r2, 1.0 / 40320.0); cp = fma(cp, r2, -1.0 / 720.0); cp = fma(cp, r2, 1.0 / 24.0); cp = fma(cp, r2, -0.5);
    const double cr = fma(r2, cp, 1.0);
    const int n = (int)((long long)q & 3);
    s = (n == 0) ? sr : (n == 1) ? cr : (n == 2) ? -sr : -cr;
    c = (n == 0) ? cr : (n == 1) ? -sr : (n == 2) ? -cr : sr;
}

template <bool F8W = false> __device__ __forceinline__ void transpose_item(const float* W, int K, int N, bf16* WT, int n0, int src0, int kb, LAS float* scr, int lane) {
    const int k0 = 64 * kb;
    float wv[32];
#pragma unroll
    for (int i = 0; i < 32; ++i) { const int kk = 2 * i + (lane >> 5); wv[i] = W[(size_t)(k0 + kk) * N + src0 + (lane & 31)]; }
#pragma unroll
    for (int i = 0; i < 32; ++i) { const int kk = 2 * i + (lane >> 5); scr[kk * 33 + (lane & 31)] = wv[i]; }
    LDS_WAIT(); asm volatile("" ::: "memory");
    const int c = lane & 7;
#pragma unroll
    for (int j = 0; j < 4; ++j) { const int n = (lane >> 3) + 8 * j; const LAS float* s = scr + (8 * c) * 33 + n;
        if (F8W) { unsigned w0 = 0u, w1 = 0u;
            w0 = __builtin_amdgcn_cvt_pk_fp8_f32(s[0 * 33] * 64.0f, s[1 * 33] * 64.0f, w0, false); w0 = __builtin_amdgcn_cvt_pk_fp8_f32(s[2 * 33] * 64.0f, s[3 * 33] * 64.0f, w0, true);
            w1 = __builtin_amdgcn_cvt_pk_fp8_f32(s[4 * 33] * 64.0f, s[5 * 33] * 64.0f, w1, false); w1 = __builtin_amdgcn_cvt_pk_fp8_f32(s[6 * 33] * 64.0f, s[7 * 33] * 64.0f, w1, true);
            u32x2q o8; o8.x = w0; o8.y = w1; *(GAS u32x2q*)((GAS unsigned char*)WT + (size_t)(n0 + n) * K + k0 + 8 * c) = o8; }
        else { v4u o; o.x = pk2(s[0 * 33], s[1 * 33]); o.y = pk2(s[2 * 33], s[3 * 33]); o.z = pk2(s[4 * 33], s[5 * 33]); o.w = pk2(s[6 * 33], s[7 * 33]);
            *(GAS v4u*)(WT + (size_t)(n0 + n) * K + k0 + 8 * c) = o; } }
    LDS_WAIT(); asm volatile("" ::: "memory");
}
__device__ __forceinline__ int src_ffn_in(int n0) { const int t = n0 >> 8, h = (n0 >> 7) & 1, i0 = n0 & 127; return h * FF + 128 * t + i0; }
__device__ __forceinline__ int src_win(int n0) {
    const int t = n0 >> 8, ct = n0 & 255;
    if (t < 2) return n0;
    const int bj = ct >> 7, wc = (ct >> 5) & 3;
    if (t < 4) return 512 + ((t - 2) * 4 + wc) * 64 + 32 * bj;
    if (t == 4) return (wc < 2 ? 1024 + wc * 64 : 1152 + (wc - 2) * 64) + 32 * bj;
    return 1280 + (n0 - 5 * 256);
}

__device__ __forceinline__ void convert_item(Frame& F, int group, int r, LAS float* scr) {
    constexpr int I_FI = (DM / 64) * (2 * FF / 32), I_FO = (FF / 64) * (DM / 32), I_IN = (DM / 64) * (INW / 32), I_GLU = (512 / 64) * (512 / 32), I_P = (512 / 64) * (DM / 32), I_O = (DM / 64) * (DM / 32);
    if (group == 0) { const int nblk = 2 * FF / 32, kb = r / nblk, n0 = (r % nblk) * 32; transpose_item<true>(INP(11), DM, 2 * FF, (bf16*)(F.ws + WS_W1I), n0, src_ffn_in(n0), kb, scr, F.lane); return; }
    if (group == 1) {
        if (r < I_FO) { const int nblk = DM / 32, kb = r / nblk, n0 = (r % nblk) * 32; transpose_item<true>(INP(12), FF, DM, (bf16*)(F.ws + WS_W1O), n0, n0, kb, scr, F.lane); return; } r -= I_FO;
        { const int nblk = INW / 32, kb = r / nblk, n0 = (r % nblk) * 32;
          if (n0 < 512) transpose_item(INP(14), DM, INW, (bf16*)(F.ws + WS_WIN), n0, src_win(n0), kb, scr, F.lane);
          else if (n0 < 1024) transpose_item<true>(INP(14), DM, INW, (bf16*)(F.ws + WS_WIN8), 2048 + (n0 - 512), src_win(n0), kb, scr, F.lane);
          else if (n0 < 1280) transpose_item(INP(14), DM, INW, (bf16*)(F.ws + WS_WIN), n0 - 512, src_win(n0), kb, scr, F.lane);
          else transpose_item<true>(INP(14), DM, INW, (bf16*)(F.ws + WS_WIN8), n0 - 1280, src_win(n0), kb, scr, F.lane); } return; }
    if (group == 2) { const int nblk = 512 / 32, kb = r / nblk, n0 = (r % nblk) * 32; transpose_item(INP(23), 512, 512, (bf16*)(F.ws + WS_WGLU), n0, n0, kb, scr, F.lane); return; }
    if (group == 4) { const int nblk = DM / 32, kb = r / nblk, n0 = (r % nblk) * 32; transpose_item<true>(INP(33), FF, DM, (bf16*)(F.ws + WS_W2O), n0, n0, kb, scr, F.lane); return; }
    if (r < I_FI) { const int nblk = 2 * FF / 32, kb = r / nblk, n0 = (r % nblk) * 32; transpose_item<true>(INP(32), DM, 2 * FF, (bf16*)(F.ws + WS_W2I), n0, src_ffn_in(n0), kb, scr, F.lane); return; } r -= I_FI;
    if (r < 2 * I_P) { const int which = r / I_P; r -= which * I_P; const int nblk = DM / 32, kb = r / nblk, n0 = (r % nblk) * 32;
        transpose_item<true>(which ? INP(29) : INP(25), 512, DM, (bf16*)(F.ws + (which ? WS_WAP : WS_WS5P)), n0, n0, kb, scr, F.lane); return; } r -= 2 * I_P;
    { const int nblk = DM / 32, kb = r / nblk, n0 = (r % nblk) * 32; transpose_item<true>(INP(30), DM, DM, (bf16*)(F.ws + WS_WOUT), n0, n0, kb, scr, F.lane); }
}
__device__ __host__ constexpr int convert_count(int group) {
    constexpr int I_FI = (DM / 64) * (2 * FF / 32), I_FO = (FF / 64) * (DM / 32), I_IN = (DM / 64) * (INW / 32), I_GLU = (512 / 64) * (512 / 32), I_P = (512 / 64) * (DM / 32), I_O = (DM / 64) * (DM / 32);
    return group == 0 ? I_FI : group == 1 ? I_FO + I_IN : group == 2 ? I_GLU : group == 3 ? I_FI + 2 * I_P + I_O : I_FO;
}
__device__ __forceinline__ void rope_table(Frame& F, int wgi, int nwg);
__device__ __forceinline__ void s5_tables(Frame& F, int wgi, int nwg);
__device__ __forceinline__ void convert_idle(Frame& F, int group, int c, int c0) {
    if (c < c0) return;
    LAS float* scr = (LAS float*)(F.lds + RING_OFF + F.wave * 16384);
    const int nw = (F.G - c0) * NWAVES;
    for (int it = (c - c0) * NWAVES + F.wave; it < convert_count(group); it += nw) convert_item(F, group, it, scr);
    if (group == 1) rope_table(F, c - c0, F.G - c0);
    if (group == 2) { __syncthreads();
        const int nd = F.G > 198 ? F.G - 198 : 0, nv = (F.G - c0) + nd;
        if (c < 198) s5_tables(F, c - c0, nv);
        else { s5_tables(F, (198 - c0) + 2 * (c - 198), nv); __syncthreads(); s5_tables(F, (198 - c0) + 2 * (c - 198) + 1, nv); } }
}
template <bool FAST> __device__ __forceinline__ void s5_param(Frame& F, int g, int p, double& lrd, double& lid, double& fre, double& fim) {
    const double dt = FAST ? (double)__expf(INP(15)[g]) : exp((double)INP(15)[g]); const double lr = fmin((double)INP(16)[g * NP + p], -1e-4), li = (double)INP(17)[g * NP + p];
    lrd = lr * dt; lid = li * dt;
    const double mag = FAST ? (double)__expf((float)lrd) : exp(lrd); double s, c; sincos_d(lid, s, c);
    const double nr = mag * c - 1.0, ni = mag * s, den = lr * lr + li * li;
    fre = (nr * lr + ni * li) / den; fim = (ni * lr - nr * li) / den;
}
template <bool FAST> __device__ __forceinline__ void s5_pow(double lrd, double lid, int tau, double& re, double& im) { const double mag = FAST ? (double)__expf((float)(lrd * (double)tau)) : exp(lrd * (double)tau); double s, c; sincos_d(lid * (double)tau, s, c); re = mag * c; im = mag * s; }

__device__ __forceinline__ void rope_table(Frame& F, int wgi, int nwg) {
    const int gt = wgi * NWAVES * 64 + F.tid, NGT = nwg * NWAVES * 64;
    {
        float* rope = (float*)(F.ws + WS_ROPE);
        for (int i = gt; i < SEQ * 8; i += NGT) { const int pos = i >> 3, k = i & 7;
            const double f = k == 0 ? 1.0 : k == 1 ? 0.19392274474868576 : k == 2 ? 0.03760603093086393 : k == 3 ? 0.007292664737217109 : k == 4 ? 0.001414213562373095 : k == 5 ? 0.0002742481756762073 : k == 6 ? 5.318295896944988e-05 : 1.031338537721246e-05;
            double s, c; sincos_d((double)pos * f, s, c); rope[pos * 16 + k] = (float)c; rope[pos * 16 + 8 + k] = (float)s; }
    }
}
__device__ __forceinline__ void s5_tables(Frame& F, int wgi, int nwg) {
    const int gt = wgi * NWAVES * 64 + F.tid, NGT = nwg * NWAVES * 64;
    {
        const float* bre = INP(18); const float* bim = INP(19); const float* cre = INP(20); const float* cim = INP(21); const float* dsk = INP(22);
        bf16* Kt = (bf16*)(F.ws + WS_KT); bf16* Min = (bf16*)(F.ws + WS_MIN); bf16* Mout = (bf16*)(F.ws + WS_MOUT);
    {
        LAS float* Lc = (LAS float*)(F.lds + RING_OFF);
        LAS float* Lb = Lc + 2048;
        LAS float* Lz = Lb + 2048 + F.wave * 128;
        __syncthreads();
        for (int task = wgi; task < NG * 8; task += nwg) { const int g = task >> 3, tau = (task & 7) * 8 + F.wave, c = F.lane & 15, cq = F.lane >> 4;
            for (int i = F.tid; i < 1024; i += NWAVES * 64) { const int pp = i >> 4, cc = i & 15;
                Lc[(pp * 16 + cc) * 2] = cre[(size_t)(g * GC + cc) * NP + pp]; Lc[(pp * 16 + cc) * 2 + 1] = cim[(size_t)(g * GC + cc) * NP + pp];
                Lb[pp * 32 + cc] = bre[(size_t)(g * NP + pp) * GC + cc]; Lb[pp * 32 + 16 + cc] = bim[(size_t)(g * NP + pp) * GC + cc]; }
            { double lrd, lid, fre, fim, pr, pi; s5_param<true>(F, g, F.lane, lrd, lid, fre, fim); s5_pow<true>(lrd, lid, tau, pr, pi);
              Lz[F.lane * 2] = (float)(pr * fre - pi * fim); Lz[F.lane * 2 + 1] = (float)(pr * fim + pi * fre); }
            LDS_WAIT(); __syncthreads();
            f32x4 acc = {0.f, 0.f, 0.f, 0.f};
#pragma unroll 8
            for (int p = 0; p < NP; ++p) { const float ar = Lz[2 * p], ai = Lz[2 * p + 1]; const float c_r = Lc[(p * 16 + c) * 2], c_i = Lc[(p * 16 + c) * 2 + 1];
                const float er = c_r * ar - c_i * ai, ei = c_r * ai + c_i * ar;
                const f32x4 vbr = *(const LAS f32x4*)(Lb + p * 32 + 4 * cq), vbi = *(const LAS f32x4*)(Lb + p * 32 + 16 + 4 * cq);
                acc += vbr * er - vbi * ei; }
            if (tau == 0 && (c >> 2) == cq) { const float dv = dsk[g * GC + c];
#pragma unroll
                for (int k = 0; k < 4; ++k) acc[k] += ((c & 3) == k) ? dv : 0.f; }
            u32x2q w; w.x = pk2(acc[0], acc[1]); w.y = pk2(acc[2], acc[3]);
            *(GAS u32x2q*)(Kt + ((size_t)(g * 65 + tau + 1) * 16 + c) * 16 + 4 * cq) = w;
            if (tau == 0) { u32x2q zz; zz.x = 0u; zz.y = 0u; *(GAS u32x2q*)(Kt + ((size_t)(g * 65) * 16 + c) * 16 + 4 * cq) = zz; }
            __syncthreads();
        } }
        for (int i = gt; i < NG * NP * 64; i += NGT) { const int g = i >> 12, p = (i >> 6) & 63, s = i & 63;
            double lrd, lid, fre, fim, pr, pi; s5_param<true>(F, g, p, lrd, lid, fre, fim); s5_pow<true>(lrd, lid, 63 - s, pr, pi);
            const float ar = (float)(pr * fre - pi * fim), ai = (float)(pr * fim + pi * fre);
            const float* br = bre + (size_t)(g * NP + p) * GC; const float* bi = bim + (size_t)(g * NP + p) * GC;
            f32x4 vr[4], vi[4];
#pragma unroll
            for (int k = 0; k < 4; ++k) { const f32x4 x = *(const f32x4*)(br + 4 * k), y = *(const f32x4*)(bi + 4 * k); vr[k] = x * ar - y * ai; vi[k] = y * ar + x * ai; }
            v4u o;
            GAS v4u* dre = (GAS v4u*)(Min + ((size_t)(g * 128 + p) * 1024 + s * 16)); GAS v4u* dim = (GAS v4u*)(Min + ((size_t)(g * 128 + 64 + p) * 1024 + s * 16));
            o.x = pk2(vr[0][0], vr[0][1]); o.y = pk2(vr[0][2], vr[0][3]); o.z = pk2(vr[1][0], vr[1][1]); o.w = pk2(vr[1][2], vr[1][3]); dre[0] = o;
            o.x = pk2(vr[2][0], vr[2][1]); o.y = pk2(vr[2][2], vr[2][3]); o.z = pk2(vr[3][0], vr[3][1]); o.w = pk2(vr[3][2], vr[3][3]); dre[1] = o;
            o.x = pk2(vi[0][0], vi[0][1]); o.y = pk2(vi[0][2], vi[0][3]); o.z = pk2(vi[1][0], vi[1][1]); o.w = pk2(vi[1][2], vi[1][3]); dim[0] = o;
            o.x = pk2(vi[2][0], vi[2][1]); o.y = pk2(vi[2][2], vi[2][3]); o.z = pk2(vi[3][0], vi[3][1]); o.w = pk2(vi[3][2], vi[3][3]); dim[1] = o; }
    }
    {
        const float* cre = INP(20); const float* cim = INP(21); bf16* Mout = (bf16*)(F.ws + WS_MOUT);
        LAS float* pw = (LAS float*)(F.lds + RING_OFF);
        __syncthreads();
        for (int task = wgi; task < NG * 8; task += nwg) { const int g = task >> 3, t0 = (task & 7) * 8;
            { const int tl = F.tid >> 6, p = F.tid & 63; double lrd, lid, fre, fim, pr, pi; s5_param<true>(F, g, p, lrd, lid, fre, fim); s5_pow<true>(lrd, lid, t0 + tl + 1, pr, pi);
              pw[(tl * 64 + p) * 2] = (float)pr; pw[(tl * 64 + p) * 2 + 1] = (float)pi; }
            LDS_WAIT(); __syncthreads();
#pragma unroll 1
            for (int k = 0; k < 2; ++k) { const int idx = F.tid + 512 * k, tl = idx >> 7, c = (idx >> 3) & 15, p = (idx & 7) * 8;
                const float* cr = cre + (size_t)(g * GC + c) * NP + p; const float* ci = cim + (size_t)(g * GC + c) * NP + p;
                float re[8], im[8];
#pragma unroll
                for (int j = 0; j < 8; ++j) { const float a_r = pw[(tl * 64 + p + j) * 2], a_i = pw[(tl * 64 + p + j) * 2 + 1], c_r = cr[j], c_i = ci[j]; re[j] = c_r * a_r - c_i * a_i; im[j] = -(c_r * a_i + c_i * a_r); }
                bf16* d = Mout + (size_t)((g * 64 + t0 + tl) * GC + c) * 128 + p;
                v4u o; o.x = pk2(re[0], re[1]); o.y = pk2(re[2], re[3]); o.z = pk2(re[4], re[5]); o.w = pk2(re[6], re[7]); *(GAS v4u*)d = o;
                o.x = pk2(im[0], im[1]); o.y = pk2(im[2], im[3]); o.z = pk2(im[4], im[5]); o.w = pk2(im[6], im[7]); *(GAS v4u*)(d + 64) = o; }
            __syncthreads();
        }
    }
}
__device__ __forceinline__ void p0_prologue(Frame& F) {
    {
        LAS float* sc = (LAS float*)(F.lds + RING_OFF);
        LAS float* red = (LAS float*)(F.lds + RING_OFF + 40960);
        const float* w_ada = INP(8); const float* b_ada = INP(9); float* mod = (float*)(F.ws + WS_MOD);
        bool did = false;
        for (int it = F.vcu; it < NMOD / 64; it += F.G) {
            if (!did) {
                for (int i = F.tid; i < NSTREAM * DM; i += NWAVES * 64) { const int s = i >> 10, k = i & 1023; const float c = s < NB ? INP(6)[s * DM + k] : INP(7)[(s - NB) * DM + k]; sc[i] = c / (1.0f + __expf(-c)); }
                __syncthreads(); did = true;
            }
            const int j = it * 64 + F.lane; float acc[NSTREAM];
#pragma unroll
            for (int s = 0; s < NSTREAM; ++s) acc[s] = 0.f;
            const int k0 = F.wave * 128;
#pragma unroll 1
            for (int kb = 0; kb < 128; kb += 32) { float wv[32];
#pragma unroll
                for (int k = 0; k < 32; ++k) wv[k] = w_ada[(size_t)(k0 + kb + k) * NMOD + j];
#pragma unroll
                for (int s = 0; s < NSTREAM; ++s)
#pragma unroll
                    for (int k4 = 0; k4 < 8; ++k4) { const f32x4 c4 = *(const LAS f32x4*)(sc + s * DM + k0 + kb + 4 * k4);
                        acc[s] += c4[0] * wv[4 * k4] + c4[1] * wv[4 * k4 + 1] + c4[2] * wv[4 * k4 + 2] + c4[3] * wv[4 * k4 + 3]; } }
#pragma unroll
            for (int s = 0; s < NSTREAM; ++s) red[(F.wave * NSTREAM + s) * 64 + F.lane] = acc[s];
            __syncthreads();
            for (int i = F.tid; i < NSTREAM * 64; i += NWAVES * 64) { const int s = i >> 6, l = i & 63; float v = b_ada[it * 64 + l];
#pragma unroll
                for (int w = 0; w < NWAVES; ++w) v += red[(w * NSTREAM + s) * 64 + l];
                if (it < 2 * DM / 64) __hip_atomic_store((gu32*)(mod + (size_t)s * NMOD + it * 64 + l), __float_as_uint(v), RLX_AGENT);
                else mod[(size_t)s * NMOD + it * 64 + l] = v; }
            if (it < 2 * DM / 64) { VM_WAIT(); __syncthreads(); if (F.tid == 0) (void)__hip_atomic_fetch_add((gu32*)(F.ctl + CW_ADA), 1u, RLX_AGENT); }
            __syncthreads();
        }
        __syncthreads();
    }
    const int gw = F.vcu * NWAVES + F.wave, NGW = F.G * NWAVES;
    const int gt = F.vcu * NWAVES * 64 + F.tid, NGT = F.G * NWAVES * 64;
    {
        LAS float* scr = (LAS float*)(F.lds + RING_OFF + F.wave * 16384);
        constexpr int NA = NMOD / 64;
        if (F.G > NA) { const int nfree = (F.G - NA) * NWAVES, n2 = 2 * nfree < convert_count(0) ? 2 * nfree : convert_count(0);
            if (F.vcu >= NA) { for (int it = (F.vcu - NA) * NWAVES + F.wave; it < n2; it += nfree) convert_item(F, 0, it, scr); }
            else { for (int it = n2 + F.vcu * NWAVES + F.wave; it < convert_count(0); it += NA * NWAVES) convert_item(F, 0, it, scr); } }
        else { for (int it = F.vcu * NWAVES + F.wave; it < convert_count(0); it += F.G * NWAVES) convert_item(F, 0, it, scr); }
    }
    {
        bf16* KXS = (bf16*)(F.ws + WS_KXS); bf16* VTS = (bf16*)(F.ws + WS_VTS);
        const float* ck = INP(2); const float* cv = INP(3);
        for (int i = gt; i < DB * 128 * 128; i += NGT) { const int sb = i >> 14, w = (i >> 7) & 127, c = i & 127, kvh = c >> 6, d = c & 63;
            const float kvv = ck[i], vv = cv[i];
            KXS[(size_t)(sb * 192 + w) * 128 + c] = (bf16)f2bf(kvv);
            VTS[(size_t)((sb * 2 + kvh) * 64 + d) * 192 + w] = (bf16)f2bf(vv);
            if (w >= 64) { F.out[O_KWS + (size_t)(sb * 128 + (w - 64)) * 128 + c] = kvv; F.out[O_VWS + (size_t)(sb * 128 + (w - 64)) * 128 + c] = vv; } }
    }
}
__device__ __forceinline__ void modulate_pass(Frame& F, int sub, bool from_x, const float* gnorm);
__device__ __forceinline__ void p0b_prologue(Frame& F) { modulate_pass(F, 0, true, INP(10)); }

__device__ __forceinline__ void hp_sample_init(Frame& F) {
    const int gt = F.vcu * NWAVES * 64 + F.tid, NGT = F.G * NWAVES * 64;
    {
        bf16* HP = (bf16*)(F.ws + WS_HP);
        for (int i = gt; i < DB * NG * NP; i += NGT) { const int sb = i >> 11, g = (i >> 6) & 31, p = i & 63;
            HP[(size_t)(g * NCHP + 256 + sb) * 128 + p] = (bf16)f2bf(INP(4)[i]); HP[(size_t)(g * NCHP + 256 + sb) * 128 + 64 + p] = (bf16)f2bf(INP(5)[i]); }
    }
}
__device__ __forceinline__ void modulate_pass(Frame& F, int sub, bool from_x, const float* gnorm) {
    const int gw = F.vcu * NWAVES + F.wave, NGW = F.G * NWAVES;
    const float* mod = (const float*)(F.ws + WS_MOD); bf16* XN = (bf16*)(F.ws + WS_XN); const bf16* Hb = (const bf16*)F.out;
    for (int r0 = 2 * gw; r0 < M; r0 += 2 * NGW) {
        f32x4 v[2][4]; float ss[2];
#pragma unroll
        for (int q = 0; q < 2; ++q) { const int r = r0 + q;
            if (from_x) { const float* src = r < MP ? INP(0) + (size_t)r * DM : INP(1) + (size_t)(r - MP) * DM;
                const GAS f32x4* xr = (const GAS f32x4*)src + 2 * F.lane;
                v[q][0] = xr[0]; v[q][1] = xr[1]; v[q][2] = xr[128]; v[q][3] = xr[129]; }
            else { const GAS v4u* xr = (const GAS v4u*)(Hb + (size_t)r * DM) + F.lane;
#pragma unroll
                for (int j = 0; j < 2; ++j) { const v4u x = xr[64 * j];
                    v[q][2 * j] = (f32x4){__uint_as_float(x.x << 16), __uint_as_float(x.x & 0xffff0000u), __uint_as_float(x.y << 16), __uint_as_float(x.y & 0xffff0000u)};
                    v[q][2 * j + 1] = (f32x4){__uint_as_float(x.z << 16), __uint_as_float(x.z & 0xffff0000u), __uint_as_float(x.w << 16), __uint_as_float(x.w & 0xffff0000u)}; } } }
#pragma unroll
        for (int q = 0; q < 2; ++q) { float s_ = 0.f;
#pragma unroll
            for (int j = 0; j < 4; ++j) s_ += (v[q][j].x * v[q][j].x + v[q][j].y * v[q][j].y) + (v[q][j].z * v[q][j].z + v[q][j].w * v[q][j].w);
            ss[q] = s_; }
#pragma unroll
        for (int q = 0; q < 2; ++q) { const int r = r0 + q; const int s = row_stream(r);
            const float* sh = mod + (size_t)s * NMOD + (sub * 3 + 0) * DM; const float* scl = mod + (size_t)s * NMOD + (sub * 3 + 1) * DM;
            const float rstd = 1.0f / sqrtf(wave_sum(ss[q]) * (1.0f / DM) + RMS_EPS);
            GAS v4u* o16 = (GAS v4u*)(XN + (size_t)r * DM) + F.lane;
#pragma unroll
            for (int j = 0; j < 2; ++j) { const int c = 512 * j + 8 * F.lane; f32x4 y[2];
#pragma unroll
                for (int h = 0; h < 2; ++h) { const f32x4 g = *(const f32x4*)(gnorm + c + 4 * h), a = *(const f32x4*)(scl + c + 4 * h), b = *(const f32x4*)(sh + c + 4 * h); y[h] = v[q][2 * j + h] * rstd * g * (a + 1.0f) + b; }
                if (from_x) { unsigned w0 = 0u, w1 = 0u;
                    w0 = __builtin_amdgcn_cvt_pk_fp8_f32(y[0].x * 16.0f, y[0].y * 16.0f, w0, false); w0 = __builtin_amdgcn_cvt_pk_fp8_f32(y[0].z * 16.0f, y[0].w * 16.0f, w0, true);
                    w1 = __builtin_amdgcn_cvt_pk_fp8_f32(y[1].x * 16.0f, y[1].y * 16.0f, w1, false); w1 = __builtin_amdgcn_cvt_pk_fp8_f32(y[1].z * 16.0f, y[1].w * 16.0f, w1, true);
                    u32x2q o8; o8.x = w0; o8.y = w1; *(GAS u32x2q*)((GAS unsigned char*)XN + (size_t)r * DM + c) = o8; }
                else { v4u o; o.x = pk2(y[0].x, y[0].y); o.y = pk2(y[0].z, y[0].w); o.z = pk2(y[1].x, y[1].y); o.w = pk2(y[1].z, y[1].w); o16[64 * j] = o; } } }
    }
}
__device__ __forceinline__ void final_norm_pass(Frame& F, const bf16* src16, float* out) {
    const int gw = F.vcu * NWAVES + F.wave, NGW = F.G * NWAVES; const float* gnorm = INP(34);
    for (int r0 = 2 * gw; r0 < M; r0 += 2 * NGW) {
        v4u w[2][2]; float ss[2];
#pragma unroll
        for (int q = 0; q < 2; ++q) { const GAS v4u* xr = (const GAS v4u*)(src16 + (size_t)(r0 + q) * DM) + F.lane;
            w[q][0] = xr[0]; w[q][1] = xr[64]; }
#pragma unroll
        for (int q = 0; q < 2; ++q) { float s_ = 0.f;
#pragma unroll
            for (int j = 0; j < 2; ++j) { const v4u x = w[q][j]; const float e0 = __uint_as_float(x.x << 16), e1 = __uint_as_float(x.x & 0xffff0000u), e2 = __uint_as_float(x.y << 16), e3 = __uint_as_float(x.y & 0xffff0000u),
                    e4 = __uint_as_float(x.z << 16), e5 = __uint_as_float(x.z & 0xffff0000u), e6 = __uint_as_float(x.w << 16), e7 = __uint_as_float(x.w & 0xffff0000u);
                s_ += ((e0 * e0 + e1 * e1) + (e2 * e2 + e3 * e3)) + ((e4 * e4 + e5 * e5) + (e6 * e6 + e7 * e7)); }
            ss[q] = s_; }
#pragma unroll
        for (int q = 0; q < 2; ++q) { const float rstd = 1.0f / sqrtf(wave_sum(ss[q]) * (1.0f / DM) + RMS_EPS);
            GAS f32x4* yo = (GAS f32x4*)(out + (size_t)(r0 + q) * DM);
#pragma unroll
            for (int j = 0; j < 2; ++j) { const v4u x = w[q][j]; const int c = 512 * j + 8 * F.lane;
                const f32x4 g0 = *(const f32x4*)(gnorm + c), g1 = *(const f32x4*)(gnorm + c + 4);
                const f32x4 v0 = {__uint_as_float(x.x << 16), __uint_as_float(x.x & 0xffff0000u), __uint_as_float(x.y << 16), __uint_as_float(x.y & 0xffff0000u)};
                const f32x4 v1 = {__uint_as_float(x.z << 16), __uint_as_float(x.z & 0xffff0000u), __uint_as_float(x.w << 16), __uint_as_float(x.w & 0xffff0000u)};
                yo[(c >> 2)] = v0 * rstd * g0; yo[(c >> 2) + 1] = v1 * rstd * g1; } }
    }
}

typedef float f32x16 __attribute__((ext_vector_type(16)));

__device__ __forceinline__ void attn_wave_qb(Frame& F, int ck, int head, int qb, bf16* Ob) {
    const int lane = F.lane, l31 = lane & 31, hi = lane >> 5, kvh = head >> 2;
    const bf16* Qb = (const bf16*)(F.ws + WS_Q); const bf16* KX = (const bf16*)(F.ws + WS_KX);
    int r0, kstart; const bf16* kbase; const bf16* vtb; size_t vstr;
    if (ck < 256) { const int b = ck >> 7, n = ck & 127; r0 = b * SEQ + 64 * n; kstart = 64 * (n - 2);
        kbase = KX + (size_t)(b * SEQ) * 128 + kvh * 64; vtb = (const bf16*)(F.ws + WS_VTP) + (size_t)((b * 2 + kvh) * 64) * SEQ; vstr = SEQ; }
    else { const int sb = ck - 256; r0 = MP + 64 * sb; kstart = 0; kbase = (const bf16*)(F.ws + WS_KXS) + (size_t)(sb * 192) * 128 + kvh * 64; vtb = (const bf16*)(F.ws + WS_VTS) + (size_t)((sb * 2 + kvh) * 64) * 192; vstr = 192; }
    const float sink = INP(28)[head] * 1.4426950408889634f;
    bf16x8 qf[4];
    const bf16* qrow = Qb + (size_t)(r0 + 32 * qb + l31) * 512 + head * 64 + 8 * hi;
#pragma unroll
    for (int s = 0; s < 4; ++s) qf[s] = *(const GAS bf16x8*)(qrow + 16 * s);
    f32x16 S[6];
#pragma unroll
    for (int kb = 0; kb < 6; ++kb) {
        const int k0 = kstart + 32 * kb; const bool valid = k0 >= 0; const int kc = valid ? k0 : 0;
        const bf16* krow = kbase + (size_t)(kc + l31) * 128 + 8 * hi;
        f32x16 a = {0.f, 0.f, 0.f, 0.f, 0.f, 0.f, 0.f, 0.f, 0.f, 0.f, 0.f, 0.f, 0.f, 0.f, 0.f, 0.f};
#pragma unroll
        for (int s = 0; s < 4; ++s) { const bf16x8 kf = *(const GAS bf16x8*)(krow + 16 * s); a = __builtin_amdgcn_mfma_f32_32x32x16_bf16(kf, qf[s], a, 0, 0, 0); }
#pragma unroll
        for (int r = 0; r < 16; ++r) S[kb][r] = valid ? a[r] : -1e30f;
    }
    float mx = sink;
#pragma unroll
    for (int kb = 0; kb < 6; ++kb)
#pragma unroll
        for (int r = 0; r < 16; ++r) mx = fmaxf(mx, S[kb][r]);
    mx = fmaxf(mx, __shfl_xor(mx, 32));
    float lsum = 0.f;
#pragma unroll
    for (int kb = 0; kb < 6; ++kb)
#pragma unroll
        for (int r = 0; r < 16; ++r) { const float e = __builtin_amdgcn_exp2f(S[kb][r] - mx); S[kb][r] = e; lsum += e; }
    lsum += __shfl_xor(lsum, 32);
    lsum += __builtin_amdgcn_exp2f(sink - mx);
    const float rl = 1.0f / lsum;
    f32x16 o[2];
#pragma unroll
    for (int db = 0; db < 2; ++db)
#pragma unroll
        for (int r = 0; r < 16; ++r) o[db][r] = 0.f;
#pragma unroll
    for (int kb = 0; kb < 6; ++kb) {
        const int k0 = kstart + 32 * kb; const int kc = k0 >= 0 ? k0 : 0;
#pragma unroll
        for (int s = 0; s < 2; ++s) {
            u32x4q pw; pw.x = pg8::cvt_pk_bf16(S[kb][8 * s + 0], S[kb][8 * s + 1]); pw.y = pg8::cvt_pk_bf16(S[kb][8 * s + 2], S[kb][8 * s + 3]);
            pw.z = pg8::cvt_pk_bf16(S[kb][8 * s + 4], S[kb][8 * s + 5]); pw.w = pg8::cvt_pk_bf16(S[kb][8 * s + 6], S[kb][8 * s + 7]);
            const bf16x8 pf = __builtin_bit_cast(bf16x8, pw);
#pragma unroll
            for (int db = 0; db < 2; ++db) {
                const bf16* vp = vtb + (size_t)(32 * db + l31) * vstr + kc + 16 * s + 4 * hi;
                const u32x2q v0 = *(const GAS u32x2q*)vp, v1 = *(const GAS u32x2q*)(vp + 8);
                u32x4q vw; vw.x = v0.x; vw.y = v0.y; vw.z = v1.x; vw.w = v1.y;
                o[db] = __builtin_amdgcn_mfma_f32_32x32x16_bf16(__builtin_bit_cast(bf16x8, vw), pf, o[db], 0, 0, 0);
            }
        }
    }
    unsigned char* orow8 = (unsigned char*)Ob + (size_t)(r0 + 32 * qb + l31) * 512 + head * 64;
#pragma unroll
    for (int db = 0; db < 2; ++db)
#pragma unroll
        for (int g4 = 0; g4 < 4; ++g4) { unsigned w8 = 0u; const float r16 = rl * 16.0f;
                w8 = __builtin_amdgcn_cvt_pk_fp8_f32(o[db][4 * g4 + 0] * r16, o[db][4 * g4 + 1] * r16, w8, false); w8 = __builtin_amdgcn_cvt_pk_fp8_f32(o[db][4 * g4 + 2] * r16, o[db][4 * g4 + 3] * r16, w8, true);
            *(GAS unsigned*)((GAS unsigned char*)orow8 + 32 * db + 8 * g4 + 4 * hi) = w8; }
}

constexpr int S5_UPITCH = 2064;

__device__ __forceinline__ void s5_stage_u(Frame& F, int g, int n0) {
    const unsigned char* S5UG = (const unsigned char*)(F.ws + WS_S5U);
#pragma unroll
    for (int k = 0; k < 4; ++k) { const int idx = F.tid + 512 * k, nl = idx >> 7, off = (idx & 127) * 16; int n = n0 + nl; n = n < NCH ? n : NCH - 1;
        const v4u v = *(const GAS v4u*)(S5UG + ((size_t)(g * NCH + n) * 2048 + off));
        *(LAS v4u*)(F.lds + RING_OFF + nl * S5_UPITCH + off) = v; }
}

__device__ __forceinline__ void s5_load_u(Frame& F, int g, int n0, v4u (&su)[4]) {
    const unsigned char* S5UG = (const unsigned char*)(F.ws + WS_S5U);
#pragma unroll
    for (int k = 0; k < 4; ++k) { const int idx = F.tid + 512 * k, nl = idx >> 7, off = (idx & 127) * 16; int n = n0 + nl; n = n < NCH ? n : NCH - 1;
        su[k] = *(const GAS v4u*)(S5UG + ((size_t)(g * NCH + n) * 2048 + off)); }
}
__device__ __forceinline__ void s5_store_u(Frame& F, const v4u (&su)[4]) {
#pragma unroll
    for (int k = 0; k < 4; ++k) { const int idx = F.tid + 512 * k, nl = idx >> 7, off = (idx & 127) * 16; *(LAS v4u*)(F.lds + RING_OFF + nl * S5_UPITCH + off) = su[k]; }
}
__device__ __forceinline__ void s5_phase_a(Frame& F) {
    if (F.vcu >= 256) return;
    const int lane = F.lane, fr = lane & 15, fq = lane >> 4, g = F.vcu >> 3, j = F.vcu & 7, nblk = j == 0 ? 3 : 2;
    const bf16* Min = (const bf16*)(F.ws + WS_MIN); float* G = (float*)(F.ws + WS_G);
    const bf16* arow = Min + (size_t)(g * 128 + F.wave * 16 + fr) * 1024 + 8 * fq;
    bf16x8 Af[32]; v4u su[4];
    s5_load_u(F, g, j * 16, su);
#pragma unroll
    for (int ks = 0; ks < 32; ++ks) Af[ks] = *(const GAS bf16x8*)(arow + 32 * ks);
    const LAS unsigned char* brow = F.lds + RING_OFF + fr * S5_UPITCH + 16 * fq;
#pragma unroll 1
    for (int b = 0; b < nblk; ++b) { const int n0 = (b < 2 ? j + 8 * b : 16) * 16;
        s5_store_u(F, su);
        if (b + 1 < nblk) s5_load_u(F, g, (b + 1 < 2 ? j + 8 : 16) * 16, su);
        LDS_WAIT(); __syncthreads();
        f32x4 acc0 = {0.f, 0.f, 0.f, 0.f}, acc1 = {0.f, 0.f, 0.f, 0.f};
#pragma unroll
        for (int ks = 0; ks < 32; ks += 2) { const bf16x8 b0 = *(const LAS bf16x8*)(brow + 64 * ks), b1 = *(const LAS bf16x8*)(brow + 64 * ks + 64);
            acc0 = __builtin_amdgcn_mfma_f32_16x16x32_bf16(Af[ks], b0, acc0, 0, 0, 0); acc1 = __builtin_amdgcn_mfma_f32_16x16x32_bf16(Af[ks + 1], b1, acc1, 0, 0, 0); }
        *(GAS f32x4*)(G + (size_t)(g * NCHP + n0 + fr) * 128 + F.wave * 16 + 4 * fq) = acc0 + acc1;
        __syncthreads();
    }
}

__device__ __forceinline__ void s5_scan_unit(Frame& F, int s, int g) {
    const int p = F.lane; const int nch = s < NB ? 128 : 1; const int n0 = s < NB ? s * 128 : 256 + (s - NB);
    const float* G = (const float*)(F.ws + WS_G); bf16* HP = (bf16*)(F.ws + WS_HP);
    float are, aim; { double lrd, lid, fre, fim, pr, pi; s5_param<false>(F, g, p, lrd, lid, fre, fim); s5_pow<false>(lrd, lid, 64, pr, pi); are = (float)pr; aim = (float)pi; }
    float hr = 0.f, hi = 0.f;
    if (s >= NB) { hr = INP(4)[((s - NB) * NG + g) * NP + p]; hi = INP(5)[((s - NB) * NG + g) * NP + p]; }
    const float* gp = G + (size_t)(g * NCHP + n0) * 128 + p; bf16* hp = HP + (size_t)(g * NCHP + n0) * 128 + p;
    if (nch == 1) { hp[0] = (bf16)f2bf(hr); hp[64] = (bf16)f2bf(hi); const float gr = gp[0], gi = gp[64]; const float nr = are * hr - aim * hi + gr, ni = are * hi + aim * hr + gi; hr = nr; hi = ni; }
    else {
#pragma unroll 1
        for (int nb = 0; nb < 128; nb += 64) { float gr[64], gi[64];
#pragma unroll
            for (int k = 0; k < 64; ++k) { gr[k] = gp[(size_t)(nb + k) * 128]; gi[k] = gp[(size_t)(nb + k) * 128 + 64]; }
#pragma unroll
            for (int k = 0; k < 64; ++k) { hp[(size_t)(nb + k) * 128] = (bf16)f2bf(hr); hp[(size_t)(nb + k) * 128 + 64] = (bf16)f2bf(hi);
                const float nr = are * hr - aim * hi + gr[k], ni = are * hi + aim * hr + gi[k]; hr = nr; hi = ni; } }
    }
    float* ore = F.out + (s < NB ? O_S5RP + (size_t)(s * NG + g) * NP : O_S5RS + (size_t)((s - NB) * NG + g) * NP);
    float* oim = F.out + (s < NB ? O_S5IP + (size_t)(s * NG + g) * NP : O_S5IS + (size_t)((s - NB) * NG + g) * NP);
    ore[p] = hr; oim[p] = hi;
}

__device__ __forceinline__ float gelu_tanh_f(float x) { const float u = 0.7978845608028654f * (x + 0.044715f * x * x * x); const float e = __builtin_amdgcn_exp2f(2.885390081777927f * u); return x * (1.0f - __builtin_amdgcn_rcpf(e + 1.0f)); }

constexpr int S5_KT_OFF = 16 * S5_UPITCH + 256, S5_KT_BYTES = 65 * 512;
template <bool SAMPLE_ONLY> __device__ __forceinline__ void s5_phase_c(Frame& F, int) {
    static_assert(!SAMPLE_ONLY, "the sample chunks are block 16, shared by the group's eight workgroups");
    if (F.vcu >= 256) return;
    const int lane = F.lane, fr = lane & 15, fq = lane >> 4, q = F.wave, g = F.vcu >> 3, j = F.vcu & 7;
    const bf16* Kt = (const bf16*)(F.ws + WS_KT); const bf16* Mout = (const bf16*)(F.ws + WS_MOUT); const bf16* HP = (const bf16*)(F.ws + WS_HP); bf16* YS5 = (bf16*)(F.ws + WS_YS5);
    f32x4 acc[2][8], accs;
    v4u su[4];
    {
        bf16x8 Mf[8][4];
#pragma unroll
        for (int i = 0; i < 8; ++i) { const bf16* mrow = Mout + ((size_t)(g * 64 + 8 * i + q) * GC + fr) * 128 + 8 * fq;
#pragma unroll
            for (int kk = 0; kk < 4; ++kk) Mf[i][kk] = *(const GAS bf16x8*)(mrow + 32 * kk); }
        { v4u sk[5];
#pragma unroll
          for (int k = 0; k < 5; ++k) { const int idx = F.tid + 512 * k; sk[k] = (idx < S5_KT_BYTES / 16) ? *(const GAS v4u*)((const unsigned char*)Kt + (size_t)g * S5_KT_BYTES + idx * 16) : (v4u){0u, 0u, 0u, 0u}; }
#pragma unroll
          for (int k = 0; k < 5; ++k) { const int idx = F.tid + 512 * k; if (idx < S5_KT_BYTES / 16) *(LAS v4u*)(F.lds + RING_OFF + S5_KT_OFF + idx * 16) = sk[k]; } }
        s5_load_u(F, g, j * 16, su); s5_store_u(F, su);
#pragma unroll
        for (int b = 0; b < 2; ++b) { const int n0 = (j + 8 * b) * 16; const int n = n0 + fr;
            const bf16* hrow = HP + (size_t)(g * NCHP + n) * 128 + 8 * fq;
            bf16x8 Hf[4];
#pragma unroll
            for (int kk = 0; kk < 4; ++kk) Hf[kk] = *(const GAS bf16x8*)(hrow + 32 * kk);
#pragma unroll
            for (int i = 0; i < 8; ++i) { acc[b][i] = (f32x4){0.f, 0.f, 0.f, 0.f};
#pragma unroll
                for (int kk = 0; kk < 4; ++kk) acc[b][i] = __builtin_amdgcn_mfma_f32_16x16x32_bf16(Mf[i][kk], Hf[kk], acc[b][i], 0, 0, 0); } }
        {
            const bf16* mrow = Mout + ((size_t)(g * 64 + 8 * j + q) * GC + fr) * 128 + 8 * fq; int n = 256 + fr; n = n < NCHP ? n : NCHP - 1;
            const bf16* hrow = HP + (size_t)(g * NCHP + n) * 128 + 8 * fq;
            accs = (f32x4){0.f, 0.f, 0.f, 0.f};
#pragma unroll
            for (int kk = 0; kk < 4; ++kk) accs = __builtin_amdgcn_mfma_f32_16x16x32_bf16(*(const GAS bf16x8*)(mrow + 32 * kk), *(const GAS bf16x8*)(hrow + 32 * kk), accs, 0, 0, 0); }
    }
    const LAS unsigned char* brow = F.lds + RING_OFF + fr * S5_UPITCH + 16 * fq;
    const LAS unsigned char* kbase = F.lds + RING_OFF + S5_KT_OFF + ((q + 1 - (fq >> 1)) * 16 + fr) * 32 + 16 * (fq & 1);
#pragma unroll
    for (int b = 0; b < 3; ++b) { const int n0 = (b < 2 ? j + 8 * b : 16) * 16;
        if (b > 0) s5_store_u(F, su);
        LDS_WAIT(); __syncthreads();
        bf16x8 Bf[32];
#pragma unroll
        for (int sp = 0; sp < 32; ++sp) Bf[sp] = *(const LAS bf16x8*)(brow + 64 * sp);
        if (b < 2) {
#pragma unroll
            for (int d = -3; d <= 28; ++d) {
                if (d >= 0 || 2 * d + q >= 0) {
                    const bf16x8 a = *(const LAS bf16x8*)(kbase + d * 1024);
#pragma unroll
                    for (int i = 0; i < 8; ++i) { const int sp = 4 * i - d;
                        if (sp >= 0 && sp <= 31) acc[b][i] = __builtin_amdgcn_mfma_f32_16x16x32_bf16(a, Bf[sp], acc[b][i], 0, 0, 0); }
                }
            }
        } else {
#pragma unroll
            for (int sp = 0; sp < 32; ++sp) { const int d = 4 * j - sp;
                if (d >= -3 && (d >= 0 || 2 * d + q >= 0)) accs = __builtin_amdgcn_mfma_f32_16x16x32_bf16(*(const LAS bf16x8*)(kbase + d * 1024), Bf[sp], accs, 0, 0, 0); }
        }
        if (b + 1 < 3) s5_load_u(F, g, (b + 1 < 2 ? j + 8 : 16) * 16, su);
        if (b < 2) {
#pragma unroll
            for (int i = 0; i < 8; ++i) { const int t = 8 * i + q;
                const unsigned w0 = pg8::cvt_pk_bf16(gelu_tanh_f(acc[b][i][0]), gelu_tanh_f(acc[b][i][1])), w1 = pg8::cvt_pk_bf16(gelu_tanh_f(acc[b][i][2]), gelu_tanh_f(acc[b][i][3]));
                u32x2q w; w.x = w0; w.y = w1;
                *(GAS u32x2q*)(YS5 + ((size_t)((n0 + fr) * 64 + t) * S5W + g * GC + 4 * fq)) = w; }
        } else if (n0 + fr < NCH) { const int t = 8 * j + q;
            const unsigned w0 = pg8::cvt_pk_bf16(gelu_tanh_f(accs[0]), gelu_tanh_f(accs[1])), w1 = pg8::cvt_pk_bf16(gelu_tanh_f(accs[2]), gelu_tanh_f(accs[3]));
            u32x2q w; w.x = w0; w.y = w1;
            *(GAS u32x2q*)(YS5 + ((size_t)((n0 + fr) * 64 + t) * S5W + g * GC + 4 * fq)) = w; }
        __syncthreads();
    }
}
constexpr int AT_K_BYTES = 192 * 256, AT_V_PITCH = 392, AT_V_OFF = AT_K_BYTES, AT_V_BYTES = 128 * AT_V_PITCH;
__device__ __forceinline__ void attn_chunk_lds(Frame& F, int ck, bf16* Ob) {
    const int lane = F.lane, l31 = lane & 31, hi = lane >> 5, head = F.wave, kvh = head >> 2;
    const int b = ck >> 7, n = ck & 127, wst = n >= 2 ? 64 * (n - 2) : 0, nvalid = 64 * (n + 1) - wst;
    const bf16* Qb = (const bf16*)(F.ws + WS_Q);
    const unsigned char* kg = (const unsigned char*)(F.ws + WS_KX) + (size_t)(b * SEQ + wst) * 256;
    const unsigned char* vg = (const unsigned char*)(F.ws + WS_VTP) + ((size_t)(b * 2) * 64 * SEQ + wst) * 2;
    { v4u kr[6];
#pragma unroll
      for (int k = 0; k < 6; ++k) { const int p = F.tid + 512 * k; kr[k] = *(const GAS v4u*)(kg + (size_t)p * 16); }
      v4u vr[6];
#pragma unroll
      for (int k = 0; k < 6; ++k) { const int p = F.tid + 512 * k, row = p / 24, pc = p % 24; vr[k] = *(const GAS v4u*)(vg + (size_t)row * (SEQ * 2) + pc * 16); }
#pragma unroll
      for (int k = 0; k < 6; ++k) { const int p = F.tid + 512 * k, row = p >> 4, ch = p & 15; *(LAS v4u*)(F.lds + RING_OFF + row * 256 + ((ch ^ (row & 15)) << 4)) = kr[k]; }
#pragma unroll
      for (int k = 0; k < 6; ++k) { const int p = F.tid + 512 * k, row = p / 24, pc = p % 24; LAS unsigned long long* d = (LAS unsigned long long*)(F.lds + RING_OFF + AT_V_OFF + row * AT_V_PITCH + pc * 16);
          d[0] = (unsigned long long)vr[k].x | ((unsigned long long)vr[k].y << 32); d[1] = (unsigned long long)vr[k].z | ((unsigned long long)vr[k].w << 32); }
    }
    const float sink = INP(28)[head] * 1.4426950408889634f;
    const int r0 = b * SEQ + 64 * n;
    bf16x8 qf[2][4];
#pragma unroll
    for (int qb = 0; qb < 2; ++qb) { const bf16* qrow = Qb + (size_t)(r0 + 32 * qb + l31) * 512 + head * 64 + 8 * hi;
#pragma unroll
        for (int s = 0; s < 4; ++s) qf[qb][s] = *(const GAS bf16x8*)(qrow + 16 * s); }
    LDS_WAIT(); __syncthreads();
    const LAS unsigned char* kl = F.lds + RING_OFF; const LAS unsigned char* vl = F.lds + RING_OFF + AT_V_OFF + (kvh * 64 + l31) * AT_V_PITCH + 8 * hi;
#pragma unroll 1
    for (int qb = 0; qb < 2; ++qb) {
        f32x16 S[6];
#pragma unroll
        for (int kb = 0; kb < 6; ++kb) {
            const int row = 32 * kb + l31;
            f32x16 a = {0.f, 0.f, 0.f, 0.f, 0.f, 0.f, 0.f, 0.f, 0.f, 0.f, 0.f, 0.f, 0.f, 0.f, 0.f, 0.f};
#pragma unroll
            for (int s = 0; s < 4; ++s) { const int ch = kvh * 8 + 2 * s + hi; const bf16x8 kf = *(const LAS bf16x8*)(kl + row * 256 + ((ch ^ (row & 15)) << 4));
                a = __builtin_amdgcn_mfma_f32_32x32x16_bf16(kf, qb ? qf[1][s] : qf[0][s], a, 0, 0, 0); }
            const bool valid = 32 * kb < nvalid;
#pragma unroll
            for (int r = 0; r < 16; ++r) S[kb][r] = valid ? a[r] : -1e30f;
        }
        float mx = sink;
#pragma unroll
        for (int kb = 0; kb < 6; ++kb)
#pragma unroll
            for (int r = 0; r < 16; ++r) mx = fmaxf(mx, S[kb][r]);
        mx = fmaxf(mx, __shfl_xor(mx, 32));
        float lsum = 0.f;
#pragma unroll
        for (int kb = 0; kb < 6; ++kb)
#pragma unroll
            for (int r = 0; r < 16; ++r) { const float e = __builtin_amdgcn_exp2f(S[kb][r] - mx); S[kb][r] = e; lsum += e; }
        lsum += __shfl_xor(lsum, 32);
        lsum += __builtin_amdgcn_exp2f(sink - mx);
        const float rl = 1.0f / lsum;
        f32x16 o[2];
#pragma unroll
        for (int db = 0; db < 2; ++db)
#pragma unroll
            for (int r = 0; r < 16; ++r) o[db][r] = 0.f;
#pragma unroll
        for (int kb = 0; kb < 6; ++kb)
#pragma unroll
            for (int s = 0; s < 2; ++s) {
                u32x4q pw; pw.x = pg8::cvt_pk_bf16(S[kb][8 * s + 0], S[kb][8 * s + 1]); pw.y = pg8::cvt_pk_bf16(S[kb][8 * s + 2], S[kb][8 * s + 3]);
                pw.z = pg8::cvt_pk_bf16(S[kb][8 * s + 4], S[kb][8 * s + 5]); pw.w = pg8::cvt_pk_bf16(S[kb][8 * s + 6], S[kb][8 * s + 7]);
                const bf16x8 pf = __builtin_bit_cast(bf16x8, pw);
#pragma unroll
                for (int db = 0; db < 2; ++db) {
                    const LAS unsigned char* vp = vl + db * 32 * AT_V_PITCH + (32 * kb + 16 * s) * 2;
                    const u32x2q v0 = *(const LAS u32x2q*)vp, v1 = *(const LAS u32x2q*)(vp + 16);
                    u32x4q vw; vw.x = v0.x; vw.y = v0.y; vw.z = v1.x; vw.w = v1.y;
                    o[db] = __builtin_amdgcn_mfma_f32_32x32x16_bf16(__builtin_bit_cast(bf16x8, vw), pf, o[db], 0, 0, 0);
                }
            }
        unsigned char* orow8 = (unsigned char*)Ob + (size_t)(r0 + 32 * qb + l31) * 512 + head * 64;
#pragma unroll
        for (int db = 0; db < 2; ++db)
#pragma unroll
            for (int g4 = 0; g4 < 4; ++g4) { unsigned w8 = 0u; const float r16 = rl * 16.0f;
                w8 = __builtin_amdgcn_cvt_pk_fp8_f32(o[db][4 * g4 + 0] * r16, o[db][4 * g4 + 1] * r16, w8, false); w8 = __builtin_amdgcn_cvt_pk_fp8_f32(o[db][4 * g4 + 2] * r16, o[db][4 * g4 + 3] * r16, w8, true);
                *(GAS unsigned*)((GAS unsigned char*)orow8 + 32 * db + 8 * g4 + 4 * hi) = w8; }
    }
    __syncthreads();
}
constexpr int NPH = 12;
constexpr int CW_XCC = 13440, CW_PNL = 14336;
__device__ __forceinline__ void panel_barrier(Frame& F, unsigned* bar) {
    asm volatile("s_waitcnt vmcnt(0)" ::: "memory");
    pg8::StaticOrder S; pg8::Unit me, u; S.init(MP, DM, F.G, (int)blockIdx.x); (void)S.next(0, me);
    const unsigned myx = xb_xcc_id() + 1u; int ok = 1;
    if (F.tid < F.G) { S.init(MP, DM, F.G, F.tid); if (S.next(0, u) && u.pm == me.pm) ok = (xb_ld((unsigned*)(F.ctl + CW_XCC + F.tid)) == myx) ? 1 : 0; }
    const int same = __syncthreads_and(ok);
    if (F.tid == 0) {
        if (!same) { __builtin_amdgcn_fence(__ATOMIC_RELEASE, "agent"); asm volatile("s_waitcnt vmcnt(0)" ::: "memory"); }
        unsigned* cnt = (unsigned*)(F.ctl + CW_PNL + me.pm * 16);
        (void)xb_add(cnt, 1u);
        XB_SPIN(xb_ld(cnt) < 4u, bar);
        __builtin_amdgcn_fence(__ATOMIC_ACQUIRE, "agent");
        asm volatile("s_waitcnt vmcnt(0)" ::: "memory");
    }
    __syncthreads();
}
__global__ void __launch_bounds__(NWAVES * 64, 2) mk_fwd(Args args) {
    extern __shared__ __attribute__((aligned(16))) unsigned char lds[];
    Frame F;
    F.lds = (LAS unsigned char*)lds; F.MISC = (volatile LAS unsigned*)(F.lds + MISC_OFF);
    F.tid = threadIdx.x; F.lane = F.tid & 63; F.wave = __builtin_amdgcn_readfirstlane(F.tid >> 6);
    F.G = gridDim.x; { const int bx = blockIdx.x; F.vcu = (F.G % 8 == 0) ? (bx % 8) * (F.G / 8) + bx / 8 : bx; }
    F.ap = (KArgs)__builtin_amdgcn_kernarg_segment_ptr();
    F.out = args.out; F.ws = args.ws; F.ctl = (gu32*)(args.ws + WS_CTL);
    for (int u = F.tid; u < (LDS_BYTES - LDSCTL_OFF) / 4; u += NWAVES * 64) ((LAS unsigned*)(F.lds + LDSCTL_OFF))[u] = 0u;
    __syncthreads();
    XcdBarrier bar; bar.bar = (unsigned*)(F.ctl + CW_BAR); bar.x = 0; bar.st = nullptr;
    if (MK_SINGLE) bar = xcd_barrier_post((unsigned*)(F.ctl + CW_BAR), F.MISC + 8);
    if (MK_SINGLE && F.tid == 0) __hip_atomic_store((gu32*)(F.ctl + CW_XCC + blockIdx.x), xb_xcc_id() + 1u, RLX_AGENT);
    const int lo = args.ph_lo, hi = args.ph_hi;
#define IN(k) (lo <= (k) && (k) < hi)
#define SEAM(k) do { if (IN(k) && IN((k) + 1)) xcd_barrier(bar); } while (0)
#define PH_BEGIN(k) if (IN(k)) { LAUNDER_ARGS();
#define PH_END(k) } SEAM(k);
    unsigned char* ws = args.ws;
#define NPART(k) ((float*)(ws + WS_NPART) + (size_t)(k) * 73728)
#define NCNT(k) ((unsigned*)(ws + WS_CTL) + CW_NORM + (k) * 96 * 16)
#define NTMO ((unsigned*)(ws + WS_CTL) + CW_BAR + XB_TMO)
    const float* mod = (const float*)(ws + WS_MOD);

    PH_BEGIN(0) p0_prologue(F);
        VM_WAIT(); __syncthreads();
        if (F.tid == 0) { __builtin_amdgcn_fence(__ATOMIC_ACQUIRE, "agent"); VM_WAIT(); }
        if (F.wave == 0) pg8::nrm_wait((pg8::pgu32*)(F.ctl + CW_ADA), (unsigned)(2 * DM / 64), (pg8::pgu32*)NTMO);
        __syncthreads();
        p0b_prologue(F); PH_END(0)
    PH_BEGIN(1)
        pg8::Gemm g{(const pg8::bf16_t*)(ws + WS_XN), (const pg8::bf16_t*)(ws + WS_W1I), M, 2 * FF, DM / 2, nullptr, nullptr, 0x7A7A7A7A, 0x7A7A7A7A}; pg8::StaticOrder S; S.init(M, 2 * FF, F.G, (int)blockIdx.x);
        pg8::EpiSwiglu E{(unsigned char*)(ws + WS_A), FF};
        pg8::gemm_phase<pg8::EpiSwiglu, pg8::StaticOrder, true, true>(F.lds + RING_OFF, g, S, E);
        convert_idle(F, 1, (int)blockIdx.x, (M / 256) * (2 * FF / 256) - 5 * 256);
    PH_END(1)
    PH_BEGIN(2)
        pg8::Gemm g{(const pg8::bf16_t*)(ws + WS_A), (const pg8::bf16_t*)(ws + WS_W1O), MP, DM, FF / 2}; pg8::StaticOrder S; S.init(MP, DM, F.G, (int)blockIdx.x);
        pg8::EpiResidNorm<1, 0, true, false> E{INP(0), INP(1), nullptr, (pg8::bf16_t*)F.out, mod + 2 * DM, INP(13), mod + 3 * DM, (pg8::bf16_t*)(ws + WS_XN), nullptr, NPART(0), NCNT(0), NTMO, (const pg8::bf16_t*)(ws + WS_A), (unsigned char*)(ws + WS_XN8), 0.5f / 256.0f, 4u};
        pg8::gemm_phase<pg8::EpiResidNorm<1, 0, true, false>, pg8::StaticOrder, true, true>(F.lds + RING_OFF, g, S, E);
    PH_END(2)
    PH_BEGIN(3)
        hp_sample_init(F);
        const int c_ = (int)blockIdx.x;
        {
            pg8::Gemm g{(const pg8::bf16_t*)(ws + WS_XN), (const pg8::bf16_t*)(ws + WS_WIN), M, 768, DM}; pg8::StaticOrder S; S.init(M, 768, F.G, c_);
            pg8::EpiWin E{(pg8::bf16_t*)(ws + WS_S5U), (pg8::bf16_t*)(ws + WS_Q), (pg8::bf16_t*)(ws + WS_KX), (pg8::bf16_t*)(ws + WS_KXS), (pg8::bf16_t*)(ws + WS_VTP), (pg8::bf16_t*)(ws + WS_VTS), (pg8::bf16_t*)(ws + WS_GS5), (pg8::bf16_t*)(ws + WS_GATT),
                          INP(26), INP(27), (const float*)(ws + WS_ROPE), F.out, QSCALE};
            pg8::gemm_phase<pg8::EpiWin, pg8::StaticOrder, true, true>(F.lds + RING_OFF, g, S, E); }
        {
            pg8::Gemm g{(const pg8::bf16_t*)(ws + WS_XN8), (const pg8::bf16_t*)(ws + WS_WIN8), M, 2560, DM / 2}; pg8::StaticOrder S; S.init(M, 2560, F.G, (c_ + 58) & 255);
            pg8::EpiGate E{(pg8::bf16_t*)(ws + WS_GS5), (pg8::bf16_t*)(ws + WS_GATT), (pg8::bf16_t*)(ws + WS_Q), INP(26), (const float*)(ws + WS_ROPE), QSCALE};
            pg8::gemm_phase<pg8::EpiGate, pg8::StaticOrder, true, true>(F.lds + RING_OFF, g, S, E); }
        convert_idle(F, 2, c_, 90);
    PH_END(3)
    PH_BEGIN(4) s5_phase_a(F);
    PH_END(4)
    PH_BEGIN(5)
        if (F.wave == 0 && (F.vcu & 3) == 0) s5_scan_unit(F, F.vcu >> 7, (F.vcu >> 2) & 31);
        else if (F.wave == 1) s5_scan_unit(F, NB + (F.vcu >> 5), F.vcu & 31);
        else if (F.wave < 4 && (F.vcu & 3) == 0) { const int un = (F.vcu >> 2) * 2 + (F.wave - 2);
            attn_wave_qb(F, 256 + (un >> 4), (un >> 1) & 7, un & 1, (bf16*)(ws + WS_O8)); }
        for (int ck = F.vcu; ck < 256; ck += F.G) attn_chunk_lds(F, ck, (bf16*)(ws + WS_O8));
    PH_END(5)
    PH_BEGIN(6) s5_phase_c<false>(F, 0); PH_END(6)
    PH_BEGIN(7)
        pg8::Gemm g{(const pg8::bf16_t*)(ws + WS_YS5), (const pg8::bf16_t*)(ws + WS_WGLU), M, 512, 512}; pg8::StaticOrder S; S.init(M, 512, F.G, (int)blockIdx.x);
        pg8::EpiMix<0> E{(pg8::bf16_t*)(ws + WS_Y2), (const pg8::bf16_t*)(ws + WS_YS5), INP(24), 512};
        pg8::gemm_phase<pg8::EpiMix<0>, pg8::StaticOrder, true, true>(F.lds + RING_OFF, g, S, E);
        convert_idle(F, 3, (int)blockIdx.x, (M / 256) * 2);
    PH_END(7)
    PH_BEGIN(8)
        pg8::Gemm g{(const pg8::bf16_t*)(ws + WS_Y2), (const pg8::bf16_t*)(ws + WS_WS5P), MP, DM, 512 / 2, (const pg8::bf16_t*)(ws + WS_O8), (const pg8::bf16_t*)(ws + WS_WAP)};
        pg8::ChainOrder S; S.init(MP, DM, F.G, (int)blockIdx.x);
        pg8::EpiProj E{(const pg8::bf16_t*)(ws + WS_GS5), (const pg8::bf16_t*)(ws + WS_GATT), (unsigned char*)(ws + WS_MRG8), (const pg8::bf16_t*)(ws + WS_Y2), (const pg8::bf16_t*)(ws + WS_O8)};
        pg8::gemm_phase<pg8::EpiProj, pg8::ChainOrder, true, true>(F.lds + RING_OFF, g, S, E);
    } if (IN(8) && IN(9)) panel_barrier(F, bar.bar);
    PH_BEGIN(9)
        pg8::Gemm g{(const pg8::bf16_t*)(ws + WS_MRG8), (const pg8::bf16_t*)(ws + WS_WOUT), MP, DM, DM / 2}; pg8::StaticOrder S; S.init(MP, DM, F.G, (int)blockIdx.x);
        pg8::EpiResidNorm<0, 0, true, true> E{nullptr, nullptr, (const pg8::bf16_t*)F.out, (pg8::bf16_t*)(ws + WS_GATT), mod + 5 * DM, INP(31), mod + 6 * DM, (pg8::bf16_t*)(ws + WS_XN), nullptr, NPART(1), NCNT(1), NTMO, (const pg8::bf16_t*)(ws + WS_MRG8), nullptr, 1.0f / 1024.0f, 4u};
        pg8::gemm_phase<pg8::EpiResidNorm<0, 0, true, true>, pg8::StaticOrder, true, true>(F.lds + RING_OFF, g, S, E);
    PH_END(9)
    PH_BEGIN(10)
        pg8::Gemm g{(const pg8::bf16_t*)(ws + WS_XN), (const pg8::bf16_t*)(ws + WS_W2I), M, 2 * FF, DM / 2, nullptr, nullptr, 0x7A7A7A7A, 0x7A7A7A7A}; pg8::StaticOrder S; S.init(M, 2 * FF, F.G, (int)blockIdx.x);
        pg8::EpiSwiglu E{(unsigned char*)(ws + WS_A), FF};
        pg8::gemm_phase<pg8::EpiSwiglu, pg8::StaticOrder, true, true>(F.lds + RING_OFF, g, S, E);
        convert_idle(F, 4, (int)blockIdx.x, (M / 256) * (2 * FF / 256) - 5 * 256);
    PH_END(10)
    PH_BEGIN(11)
        pg8::Gemm g{(const pg8::bf16_t*)(ws + WS_A), (const pg8::bf16_t*)(ws + WS_W2O), MP, DM, FF / 2}; pg8::StaticOrder S; S.init(MP, DM, F.G, (int)blockIdx.x);
        pg8::EpiResidNorm<0, 1, true, false> E{nullptr, nullptr, (const pg8::bf16_t*)(ws + WS_GATT), nullptr, mod + 8 * DM, INP(34), nullptr, nullptr, F.out, NPART(2), NCNT(2), NTMO, (const pg8::bf16_t*)(ws + WS_A), nullptr, 0.5f / 256.0f, 4u};
        pg8::gemm_phase<pg8::EpiResidNorm<0, 1, true, false>, pg8::StaticOrder, true, true>(F.lds + RING_OFF, g, S, E);
    }
#undef IN
#undef SEAM
}

extern "C" void kernel_launch(void* const* d_in, const int* in_sizes, int n_in, void* d_out, int out_size, void* d_ws, size_t ws_size, hipStream_t stream) {
    static int grid = 0;
    if (grid == 0) {
        if (n_in != 35 || in_sizes[0] != MP * DM || (size_t)out_size != O_END || ws_size < WS_END) { fprintf(stderr, "kernel_launch: unexpected shapes: n_in %d in0 %d out %d ws %zu\n", n_in, n_in > 0 ? in_sizes[0] : -1, out_size, ws_size); grid = -1; return; }
        int dev = 0, cus = 0;
        if (hipGetDevice(&dev) != hipSuccess || hipDeviceGetAttribute(&cus, hipDeviceAttributeMultiprocessorCount, dev) != hipSuccess) { grid = -1; return; }
        if (hipFuncSetAttribute((const void*)mk_fwd, hipFuncAttributeMaxDynamicSharedMemorySize, LDS_BYTES) != hipSuccess) { fprintf(stderr, "kernel_launch: hipFuncSetAttribute failed\n"); grid = -1; return; }
        (void)hipGetLastError();
        if (cus != 256) { fprintf(stderr, "kernel_launch: this kernel's phase program assumes 256 CUs (got %d)\n", cus); grid = -1; return; }
        grid = cus;
    }
    if (grid < 0) return;
    if (hipMemsetAsync((char*)d_ws + WS_CTL, 0, CTL_ZERO_BYTES, stream) != hipSuccess) return;
    Args a{};
    for (int i = 0; i < 35; ++i) a.in[i] = (const float*)d_in[i];
    a.out = (float*)d_out; a.ws = (unsigned char*)d_ws;
    if (MK_SINGLE) { a.ph_lo = 0; a.ph_hi = NPH; a.li = 0; hipLaunchKernelGGL(mk_fwd, dim3(grid), dim3(NWAVES * 64), LDS_BYTES, stream, a); }
    else for (int ph = 0; ph < NPH; ++ph) { a.ph_lo = ph; a.ph_hi = ph + 1; a.li = 0; hipLaunchKernelGGL(mk_fwd, dim3(grid), dim3(NWAVES * 64), LDS_BYTES, stream, a); }
}
```
